# Optimizing an MI355X kernel written in HIP

```python
import jax, jax.numpy as jnp
from jax import lax
import numpy as np

D_MODEL = 1024
BATCH = 1
SEQ = 16384
DEPTH = 1

CHUNK = 64
HEAD_DIM = 64
RWKV_HEADS = 8
D_RWKV = RWKV_HEADS * HEAD_DIM
DECAY_LORA = 64
ICLR_LORA = 64
DECAY_SCALE = 0.606531
GN_EPS = 64e-5
ATT_HEADS = 8
D_ATT = ATT_HEADS * HEAD_DIM
IDX_HEADS = 8
IDX_DIM = 64
TOPK_MAX = 256
Q_BLOCK = 128
NORM_EPS = 1e-6

N_RWKV_COLS = 3 * D_RWKV + DECAY_LORA + ICLR_LORA + D_RWKV
N_DSA_COLS = 3 * D_ATT + D_ATT + IDX_HEADS * IDX_DIM + IDX_DIM + IDX_HEADS
N_MERGE_COLS = 2 * D_MODEL
N_IN = N_RWKV_COLS + N_DSA_COLS + N_MERGE_COLS
RWKV_SPLITS = (D_RWKV, 2 * D_RWKV, 3 * D_RWKV, 3 * D_RWKV + DECAY_LORA,
               3 * D_RWKV + DECAY_LORA + ICLR_LORA)
DSA_SPLITS = (D_ATT, 2 * D_ATT, 3 * D_ATT, 4 * D_ATT,
              4 * D_ATT + IDX_HEADS * IDX_DIM,
              4 * D_ATT + IDX_HEADS * IDX_DIM + IDX_DIM)

kernel_name = "hybrid_rwkv7_dsa_gated_block"


def rms_norm(x, g, eps=NORM_EPS):
    xf = x.astype(jnp.float32)
    y = xf * lax.rsqrt(jnp.mean(xf * xf, axis=-1, keepdims=True) + eps)
    return (y * g.astype(jnp.float32)).astype(x.dtype)


def rwkv7_time_mix(pa, mu, w0, w_up, a0, a_up, k_k, k_a, r_k, gn_w, gn_b):
    B, S, _ = pa.shape
    prev = jnp.pad(pa, ((0, 0), (1, 0), (0, 0)))[:, :S]
    pa = pa + mu * (prev - pa)
    r, k, v, wd, ad, g = jnp.split(pa, RWKV_SPLITS, axis=-1)
    w = jnp.exp(-DECAY_SCALE * jax.nn.sigmoid((w0 + jnp.tanh(wd) @ w_up).astype(jnp.float32)))
    a = jax.nn.sigmoid((a0 + ad @ a_up).astype(jnp.float32))
    kk = (k * k_k).astype(jnp.float32).reshape(B, S, RWKV_HEADS, HEAD_DIM)
    kk = kk / jnp.maximum(jnp.linalg.norm(kk, axis=-1, keepdims=True), 1e-12)
    k = (k * (1.0 + (a - 1.0) * k_a)).astype(jnp.float32)
    hs = lambda t: t.astype(jnp.float32).reshape(B, S, RWKV_HEADS, HEAD_DIM)
    r_h, w_h, k_h, v_h, a_h = hs(r), hs(w), hs(k), hs(v), hs(a)
    b_h = kk * a_h
    tm = lambda t: jnp.moveaxis(t, 1, 0)

    def step(state, inp):
        r_t, w_t, k_t, v_t, nkk_t, b_t = inp
        sa = jnp.einsum('bhvk,bhk->bhv', state, nkk_t)
        state = (state * w_t[:, :, None, :]
                 + sa[..., None] * b_t[:, :, None, :]
                 + v_t[..., None] * k_t[:, :, None, :])
        y_t = jnp.einsum('bhvk,bhk->bhv', state, r_t)
        return state, y_t

    s0 = jnp.zeros((B, RWKV_HEADS, HEAD_DIM, HEAD_DIM), jnp.float32)
    _, y = lax.scan(step, s0, (tm(r_h), tm(w_h), tm(k_h), tm(v_h), tm(-kk), tm(b_h)))
    y = jnp.moveaxis(y, 0, 1)
    mean = jnp.mean(y, axis=-1, keepdims=True)
    var = jnp.mean(jnp.square(y - mean), axis=-1, keepdims=True)
    y = (y - mean) * lax.rsqrt(var + GN_EPS)
    y = y * gn_w.reshape(RWKV_HEADS, HEAD_DIM) + gn_b.reshape(RWKV_HEADS, HEAD_DIM)
    bonus = jnp.sum(r_h * k_h * r_k.astype(jnp.float32), axis=-1, keepdims=True) * v_h
    y = (y + bonus).reshape(B, S, D_RWKV).astype(pa.dtype)
    return y, g


def dsa_sparse_attention(q, k, v, iq, ik, iw):
    B, S, H, Dh = q.shape
    topk = min(TOPK_MAX, S // 4)
    nb = S // Q_BLOCK
    key_chunk = jnp.arange(S) // CHUNK
    ik32 = ik.astype(jnp.float32)
    iw32 = iw.astype(jnp.float32) * (IDX_HEADS ** -0.5)
    blocks = lambda t: jnp.moveaxis(t.reshape((B, nb, Q_BLOCK) + t.shape[2:]), 1, 0)
    q_pos = jnp.arange(S).reshape(nb, Q_BLOCK)
    scale = HEAD_DIM ** -0.5

    def block_fn(args):
        qb, iqb, iwb, pos = args
        q_chunk = pos // CHUNK
        sc = jnp.einsum('bqhd,bsd->bqhs', iqb.astype(jnp.float32), ik32) * (IDX_DIM ** -0.5)
        idx_score = jnp.einsum('bqhs,bqh->bqs', jax.nn.relu(sc), iwb)
        adm = key_chunk[None, :] <= q_chunk[:, None]
        idx_score = jnp.where(adm[None], idx_score, -jnp.inf)
        _, sel = lax.top_k(idx_score, topk)
        valid = (sel // CHUNK) <= q_chunk[None, :, None]
        k_sel = jax.vmap(lambda kb, ib: kb[ib])(k, sel)
        v_sel = jax.vmap(lambda vb, ib: vb[ib])(v, sel)
        logits = jnp.einsum('bqhd,bqkhd->bqhk', qb.astype(jnp.float32),
                            k_sel.astype(jnp.float32)) * scale
        logits = jnp.where(valid[:, :, None, :], logits, -jnp.inf)
        p = jax.nn.softmax(logits, axis=-1)
        return jnp.einsum('bqhk,bqkhd->bqhd', p, v_sel.astype(jnp.float32)).astype(q.dtype)

    out = lax.map(block_fn, (blocks(q), blocks(iq), blocks(iw32), q_pos))
    return jnp.moveaxis(out, 0, 1).reshape(B, S, H, Dh)


def hybrid_layer(x, c, norm_w, w_ada, b_ada, w_in, mu, w0, w_up, a0, a_up, k_k, k_a,
                 r_k, gn_w, gn_b, q_gain, k_gain, w_a_out, w_b_out, w_o):
    B, S, D = x.shape
    mod = jax.nn.silu(c) @ w_ada + b_ada
    shift, scale, gate = jnp.split(mod, 3, axis=-1)
    h = rms_norm(x, norm_w) * (1.0 + scale[:, None, :]) + shift[:, None, :]
    p = h @ w_in
    pa = p[..., :N_RWKV_COLS]
    pb = p[..., N_RWKV_COLS:N_RWKV_COLS + N_DSA_COLS]
    pg = p[..., N_RWKV_COLS + N_DSA_COLS:]
    ya, ga = rwkv7_time_mix(pa, mu, w0, w_up, a0, a_up, k_k, k_a, r_k, gn_w, gn_b)
    ya = (ya * jax.nn.silu(ga)) @ w_a_out
    q, k, v, gb, iq, ik, iw = jnp.split(pb, DSA_SPLITS, axis=-1)
    heads = lambda t: t.reshape(B, S, ATT_HEADS, HEAD_DIM)
    q = rms_norm(heads(q), q_gain)
    k = rms_norm(heads(k), k_gain)
    v = heads(v)
    iq = iq.reshape(B, S, IDX_HEADS, IDX_DIM)
    yb = dsa_sparse_attention(q, k, v, iq, ik, iw).reshape(B, S, D_ATT)
    yb = (yb * jax.nn.silu(gb)) @ w_b_out
    gm_a, gm_b = jnp.split(pg, 2, axis=-1)
    merged = jax.nn.sigmoid(gm_a) * ya + jax.nn.sigmoid(gm_b) * yb
    out = merged @ w_o
    return x + gate[:, None, :] * out


def setup_inputs(seed: int = 0) -> dict:
    key = jax.random.key(seed)
    ks = jax.random.split(key, 24)
    nrm = lambda k, shape, s: jax.random.normal(k, shape, jnp.float32) * s
    L = DEPTH
    return {
        "x": nrm(ks[0], (BATCH, SEQ, D_MODEL), 1.0),
        "c": nrm(ks[1], (BATCH, D_MODEL), 1.0),
        "norm_w": 1.0 + nrm(ks[2], (L, D_MODEL), 0.02),
        "w_ada": nrm(ks[3], (L, D_MODEL, 3 * D_MODEL), 0.5 * D_MODEL ** -0.5),
        "b_ada": nrm(ks[4], (L, 3 * D_MODEL), 0.02),
        "w_in": nrm(ks[5], (L, D_MODEL, N_IN), D_MODEL ** -0.5),
        "mu": jax.random.uniform(ks[6], (L, N_RWKV_COLS), jnp.float32),
        "w0": nrm(ks[7], (L, D_RWKV), 0.5),
        "w_up": nrm(ks[8], (L, DECAY_LORA, D_RWKV), 0.5 * DECAY_LORA ** -0.5),
        "a0": nrm(ks[9], (L, D_RWKV), 0.1),
        "a_up": nrm(ks[10], (L, ICLR_LORA, D_RWKV), 0.5 * ICLR_LORA ** -0.5),
        "k_k": 0.85 + nrm(ks[11], (L, D_RWKV), 0.05),
        "k_a": 1.0 + nrm(ks[12], (L, D_RWKV), 0.05),
        "r_k": nrm(ks[13], (L, RWKV_HEADS, HEAD_DIM), 0.1),
        "gn_w": 1.0 + nrm(ks[14], (L, D_RWKV), 0.02),
        "gn_b": nrm(ks[15], (L, D_RWKV), 0.02),
        "q_gain": 1.0 + nrm(ks[16], (L, HEAD_DIM), 0.02),
        "k_gain": 1.0 + nrm(ks[17], (L, HEAD_DIM), 0.02),
        "w_a_out": nrm(ks[18], (L, D_RWKV, D_MODEL), D_RWKV ** -0.5),
        "w_b_out": nrm(ks[19], (L, D_ATT, D_MODEL), D_ATT ** -0.5),
        "w_o": nrm(ks[20], (L, D_MODEL, D_MODEL), D_MODEL ** -0.5),
    }


def reference(x, c, norm_w, w_ada, b_ada, w_in, mu, w0, w_up, a0, a_up, k_k, k_a,
              r_k, gn_w, gn_b, q_gain, k_gain, w_a_out, w_b_out, w_o):
    for l in range(DEPTH):
        x = hybrid_layer(x, c, norm_w[l], w_ada[l], b_ada[l], w_in[l], mu[l], w0[l],
                         w_up[l], a0[l], a_up[l], k_k[l], k_k[l] * 0.0 + k_a[l] if False else k_a[l],
                         r_k[l], gn_w[l], gn_b[l], q_gain[l], k_gain[l],
                         w_a_out[l], w_b_out[l], w_o[l])
    return x
```

```cpp
#include <hip/hip_runtime.h>
#include <stdint.h>
#include <stdio.h>

typedef unsigned short bf16_t;
typedef short bf16x8 __attribute__((ext_vector_type(8)));
typedef float f32x16 __attribute__((ext_vector_type(16)));
typedef float f32x4 __attribute__((ext_vector_type(4)));
typedef float f32x2 __attribute__((ext_vector_type(2)));
typedef unsigned u32x4 __attribute__((ext_vector_type(4)));
typedef unsigned u32x2 __attribute__((ext_vector_type(2)));

#ifndef N_LAUNCHES
#define N_LAUNCHES 7
#endif

constexpr int M_TOK = 16384, DM = 1024;
constexpr int NW = 6912;
constexpr int NP = 4864;
constexpr int NTHR = 512;
constexpr int LDS_BYTES = 160 * 1024;
constexpr int C_R = 0, C_K = 512, C_V = 1024, C_WD = 1536, C_AD = 1600, C_G = 1664;
constexpr int C_Q = 2176, C_AK = 2688, C_AV = 3200, C_GB = 3712, C_IQ = 4224, C_IK = 4736, C_IW = 4800;
constexpr size_t WS_CTL = 0, WS_MOD = 16384, WS_WTIN = 32768;
constexpr size_t WS_WTA = WS_WTIN + (size_t)NW * 1024 * 2;
constexpr size_t WS_WTB = WS_WTA + 1024 * 512 * 2;
constexpr size_t WS_WTO = WS_WTB + 1024 * 512 * 2;
constexpr size_t WS_H = WS_WTO + 1024 * 1024 * 2;
constexpr size_t WS_P = WS_H + (size_t)M_TOK * 1024 * 2;
constexpr size_t WS_SEL = WS_P + (size_t)M_TOK * NP * 2;
constexpr size_t WS_YA = WS_SEL + (size_t)M_TOK * 256 * 2;
constexpr size_t WS_KV = WS_YA;
constexpr size_t WS_YB = WS_YA + (size_t)M_TOK * 512 * 2;
constexpr size_t WS_WUPT = WS_YB + (size_t)M_TOK * 512 * 2;
constexpr size_t WS_AUPT = WS_WUPT + 512 * 64 * 2;
constexpr size_t WS_GL = WS_AUPT + 512 * 64 * 2;
constexpr size_t WS_END = WS_GL + 2048 * 64 * 4;
constexpr size_t WS_RM = WS_H;
constexpr size_t WS_RC = WS_H + (size_t)2048 * 8192;
static_assert(WS_END <= 268435456ull, "workspace");

struct Args {
    const float *x, *c, *norm_w, *w_ada, *b_ada, *w_in, *mu, *w0, *w_up, *a0, *a_up, *k_k, *k_a, *r_k, *gn_w, *gn_b, *q_gain, *k_gain, *w_a_out, *w_b_out, *w_o;
    float* out; unsigned char* ws; int ph_lo, ph_hi;
};

__device__ __forceinline__ float bf2f(unsigned short b) { return __uint_as_float(((unsigned)b) << 16); }
typedef __bf16 bf16x2_t __attribute__((ext_vector_type(2)));
__device__ __forceinline__ unsigned short f2bf(float f) { return __builtin_bit_cast(unsigned short, (__bf16)f); }
__device__ __forceinline__ unsigned pack2(float lo, float hi) { bf16x2_t v; v.x = (__bf16)lo; v.y = (__bf16)hi; return __builtin_bit_cast(unsigned, v); }
__device__ __forceinline__ float lo2f(unsigned w) { return __uint_as_float(w << 16); }
__device__ __forceinline__ float hi2f(unsigned w) { return __uint_as_float(w & 0xffff0000u); }
__device__ __forceinline__ float sigmoidf_(float x) { return 1.f / (1.f + __expf(-x)); }
__device__ __forceinline__ float tanhf_(float x) { return 1.f - 2.f * __builtin_amdgcn_rcpf(1.f + __expf(2.f * x)); }
__device__ __forceinline__ float wave_sum(float v) {
#pragma unroll
    for (int o = 32; o > 0; o >>= 1) v += __shfl_xor(v, o);
    return v;
}
template <int CTRL, int RM, int BM>
__device__ __forceinline__ unsigned dppu(unsigned v) { return (unsigned)__builtin_amdgcn_update_dpp(0, (int)v, CTRL, RM, BM, false); }
template <int CTRL>
__device__ __forceinline__ float dppf(float v) { return __int_as_float(__builtin_amdgcn_update_dpp(0, __float_as_int(v), CTRL, 0xf, 0xf, false)); }
__device__ __forceinline__ float sum4_dpp(float v) { v += dppf<0xB1>(v); v += dppf<0x4E>(v); return v; }
__device__ __forceinline__ float sum8_dpp(float v) { v += dppf<0xB1>(v); v += dppf<0x4E>(v); v += dppf<0x141>(v); return v; }
__device__ __forceinline__ unsigned wave_incl_scan_dpp(unsigned v) {
    unsigned s = v + dppu<0x111, 0xf, 0xf>(v);
    s += dppu<0x112, 0xf, 0xf>(v);
    s += dppu<0x113, 0xf, 0xf>(v);
    s += dppu<0x114, 0xf, 0xe>(s);
    s += dppu<0x118, 0xf, 0xc>(s);
    s += dppu<0x142, 0xa, 0xf>(s);
    s += dppu<0x143, 0xc, 0xf>(s);
    return s;
}
__device__ __forceinline__ unsigned wave_or_dpp(unsigned v) {
    v |= dppu<0xB1, 0xf, 0xf>(v); v |= dppu<0x4E, 0xf, 0xf>(v);
    v |= dppu<0x114, 0xf, 0xf>(v); v |= dppu<0x118, 0xf, 0xf>(v);
    v |= dppu<0x142, 0xa, 0xf>(v); v |= dppu<0x143, 0xc, 0xf>(v);
    return (unsigned)__builtin_amdgcn_readlane((int)v, 63);
}
__device__ __forceinline__ unsigned f2key(float f) { unsigned u = __float_as_uint(f); return (u & 0x80000000u) ? ~u : (u | 0x80000000u); }
__device__ __forceinline__ void wave_lds_sync() { __builtin_amdgcn_wave_barrier(); asm volatile("s_waitcnt lgkmcnt(0)" ::: "memory"); __builtin_amdgcn_wave_barrier(); }

template <int MODE>
__device__ __forceinline__ void convert_weightT(const float* __restrict__ src, int K, int Nsrc, bf16_t* __restrict__ dst, int Ndst, float* tile, int wg, int nwg) {
    const int ntn = Ndst / 64, ntk = K / 64;
    int tid_ = threadIdx.x; asm volatile("" : "+v"(tid_)); const int tid = tid_;
    for (int it = wg; it < ntn * ntk; it += nwg) {
        const int tn = it % ntn, tk = it / ntn;
        const int n0 = tn * 64, k0 = tk * 64;
        __syncthreads();
        {
            const int nn = tid & 63, kk0 = tid >> 6;
            const int np = n0 + nn, g = np >> 6, rho = np & 63;
            const int c = (MODE == 2) ? np : ((g << 6) + 16 * ((rho >> 2) & 3) + 4 * (rho >> 4) + (rho & 3));
            int sc = c;
            if (MODE == 1) sc = (c < 4808) ? c : ((c < 4864) ? -1 : c - 56);
#pragma unroll
            for (int i8 = 0; i8 < 8; ++i8) {
                const int kk = kk0 + 8 * i8;
                float v = (sc >= 0) ? src[(size_t)(k0 + kk) * Nsrc + sc] : 0.f;
                tile[kk * 65 + nn] = v;
            }
        }
        __syncthreads();
        {
            const int wn = tid >> 3, kq = tid & 7;
            u32x4 o;
            o.x = pack2(tile[(8 * kq + 0) * 65 + wn], tile[(8 * kq + 1) * 65 + wn]);
            o.y = pack2(tile[(8 * kq + 2) * 65 + wn], tile[(8 * kq + 3) * 65 + wn]);
            o.z = pack2(tile[(8 * kq + 4) * 65 + wn], tile[(8 * kq + 5) * 65 + wn]);
            o.w = pack2(tile[(8 * kq + 6) * 65 + wn], tile[(8 * kq + 7) * 65 + wn]);
            *(u32x4*)(dst + (size_t)(n0 + wn) * K + k0 + 8 * kq) = o;
        }
    }
}

__device__ __forceinline__ void convert_weightF(const float* __restrict__ src, int K, int Nsrc, bf16_t* __restrict__ dst, int Ndst, float* tile, int wg, int nwg) {
    const int ntn = Ndst / 64, ntk = K / 64, KS = K / 16;
    int tid_ = threadIdx.x; asm volatile("" : "+v"(tid_)); const int tid = tid_;
    for (int it = wg; it < ntn * ntk; it += nwg) {
        const int tn = it % ntn, tk = it / ntn;
        const int n0 = tn * 64, k0 = tk * 64;
        __syncthreads();
        {
            const int nn = tid & 63, kk0 = tid >> 6;
            const int np = n0 + nn, g = np >> 5, rho = np & 31;
            const int c = (g << 5) + 16 * ((rho >> 2) & 1) + (rho & 3) + 4 * (rho >> 3);
#pragma unroll
            for (int i8 = 0; i8 < 8; ++i8) { const int kk = kk0 + 8 * i8; tile[kk * 65 + nn] = src[(size_t)(k0 + kk) * Nsrc + c]; }
        }
        __syncthreads();
        {
            const int ln = tid & 63, blk = tid >> 6, Rl = blk >> 2, ksl = blk & 3;
            const int nn = 32 * Rl + (ln & 31), kb = 16 * ksl + 8 * (ln >> 5);
            u32x4 o;
            o.x = pack2(tile[(kb + 0) * 65 + nn], tile[(kb + 1) * 65 + nn]); o.y = pack2(tile[(kb + 2) * 65 + nn], tile[(kb + 3) * 65 + nn]);
            o.z = pack2(tile[(kb + 4) * 65 + nn], tile[(kb + 5) * 65 + nn]); o.w = pack2(tile[(kb + 6) * 65 + nn], tile[(kb + 7) * 65 + nn]);
            *(u32x4*)(dst + ((size_t)((n0 / 32 + Rl) * KS + k0 / 16 + ksl) * 64 + ln) * 8) = o;
        }
    }
}

__device__ __forceinline__ void phase_ada(const Args& a, float* lds, int wg, int nwg) {
    int tid_ = threadIdx.x; asm volatile("" : "+v"(tid_)); const int tid = tid_, lane = tid & 63, wave = tid >> 6;
    float* mod = (float*)(a.ws + WS_MOD);
    __syncthreads();
    for (int i = tid; i < 1024; i += NTHR) { float v = a.c[i]; lds[i] = v / (1.f + expf(-v)); }
    __syncthreads();
    for (int cg = wg; cg < 256; cg += nwg) {
        const int j0 = cg * 12;
        float acc[12];
#pragma unroll
        for (int j = 0; j < 12; ++j) acc[j] = 0.f;
        for (int k = tid; k < 1024; k += NTHR) {
            const float s = lds[k];
            const float* row = a.w_ada + (size_t)k * 3072 + j0;
            const f32x4 v0 = *(const f32x4*)row, v1 = *(const f32x4*)(row + 4), v2 = *(const f32x4*)(row + 8);
            acc[0] += s * v0.x; acc[1] += s * v0.y; acc[2] += s * v0.z; acc[3] += s * v0.w;
            acc[4] += s * v1.x; acc[5] += s * v1.y; acc[6] += s * v1.z; acc[7] += s * v1.w;
            acc[8] += s * v2.x; acc[9] += s * v2.y; acc[10] += s * v2.z; acc[11] += s * v2.w;
        }
#pragma unroll
        for (int j = 0; j < 12; ++j) acc[j] = wave_sum(acc[j]);
        if (lane == 0) {
#pragma unroll
            for (int j = 0; j < 12; ++j) lds[1024 + wave * 12 + j] = acc[j];
        }
        __syncthreads();
        if (tid < 12) {
            float s = a.b_ada[j0 + tid];
#pragma unroll
            for (int w = 0; w < 8; ++w) s += lds[1024 + w * 12 + tid];
            mod[j0 + tid] = s;
        }
        __syncthreads();
    }
}

__device__ __forceinline__ void phase_h(const Args& a, int wg, int nwg) {
    int tid_ = threadIdx.x; asm volatile("" : "+v"(tid_)); const int tid = tid_, lane = tid & 63, wave = tid >> 6;
    const float* mod = (const float*)(a.ws + WS_MOD);
    bf16_t* H = (bf16_t*)(a.ws + WS_H);
    f32x4 nw[4], sc1[4], sh[4];
#pragma unroll
    for (int i = 0; i < 4; ++i) {
        const int col = 256 * i + 4 * lane;
        nw[i] = *(const f32x4*)(a.norm_w + col);
        sh[i] = *(const f32x4*)(mod + col);
        sc1[i] = *(const f32x4*)(mod + 1024 + col);
        sc1[i] = sc1[i] + 1.0f;
    }
    for (int row = wg * 8 + wave; row < M_TOK; row += nwg * 8) {
        f32x4 v[4]; float ss = 0.f;
#pragma unroll
        for (int i = 0; i < 4; ++i) {
            v[i] = *(const f32x4*)(a.x + (size_t)row * 1024 + 256 * i + 4 * lane);
            ss += v[i].x * v[i].x + v[i].y * v[i].y + v[i].z * v[i].z + v[i].w * v[i].w;
        }
        ss = wave_sum(ss);
        const float rstd = rsqrtf(ss * (1.f / 1024.f) + 1e-6f);
#pragma unroll
        for (int i = 0; i < 4; ++i) {
            const f32x4 y = v[i] * rstd * nw[i];
            const f32x4 hv = y * sc1[i] + sh[i];
            u32x2 o; o.x = pack2(hv.x, hv.y); o.y = pack2(hv.z, hv.w);
            *(u32x2*)(H + (size_t)row * 1024 + 256 * i + 4 * lane) = o;
        }
    }
}

__device__ __forceinline__ f32x16 zero16() { f32x16 z;
#pragma unroll
    for (int r = 0; r < 16; ++r) z[r] = 0.f;
    return z; }
__device__ __forceinline__ int swz128(int row, int kc) { return row * 128 + ((kc ^ ((row >> 1) & 7)) << 4); }

__device__ __forceinline__ void phase_gemm1(const Args& a, unsigned char* lds, int wg, int nwg) {
    const bf16_t* Wt = (const bf16_t*)(a.ws + WS_WTIN);
    const bf16_t* H = (const bf16_t*)(a.ws + WS_H);
    bf16_t* P = (bf16_t*)(a.ws + WS_P);
    bf16_t* G = (bf16_t*)a.out;
    int tid_ = threadIdx.x; asm volatile("" : "+v"(tid_)); const int tid = tid_, lane = tid & 63;
    const int wave = __builtin_amdgcn_readfirstlane((int)(threadIdx.x >> 6));
    const int wn = wave & 3, wm = wave >> 2, l31 = lane & 31, hi = lane >> 5;
    for (int rnd = 0; rnd < 7 * ((256 + nwg - 1) / nwg); ++rnd) {
        int nt, mt;
        if (nwg == 256) {
            const int super = rnd * 8 + (wg & 7), slot = wg >> 3;
            mt = (super / 7) * 8 + (slot & 7); nt = (super % 7) * 4 + (slot >> 3);
        } else {
            const int tile = wg + rnd * nwg; nt = tile % 28; mt = tile / 28;
        }
        if (nt >= 27 || mt >= 64) continue;
        const int n0 = nt * 256, m0 = mt * 256;
        f32x4 acc[4][8];
#pragma unroll
        for (int i = 0; i < 4; ++i)
#pragma unroll
            for (int j = 0; j < 8; ++j) acc[i][j] = (f32x4){0.f, 0.f, 0.f, 0.f};
        const int l15 = lane & 15, q4 = lane >> 4;
        const int xs_ = (l15 >> 1) & 7;
        const int cA0 = wn * 8192 + l15 * 128 + ((q4 ^ xs_) << 4), cA1 = wn * 8192 + l15 * 128 + (((4 + q4) ^ xs_) << 4);
        const int cB0 = 32768 + wm * 16384 + l15 * 128 + ((q4 ^ xs_) << 4), cB1 = 32768 + wm * 16384 + l15 * 128 + (((4 + q4) ^ xs_) << 4);
        const int prow = lane >> 3, pch = lane & 7;
        unsigned voff[4];
#pragma unroll
        for (int i = 0; i < 4; ++i) { const int row = 8 * (wave + 8 * i) + prow; voff[i] = (unsigned)((row * 1024 + ((pch ^ ((row >> 1) & 7)) << 3)) * 2); }
        const unsigned char* wbase = (const unsigned char*)(Wt + (size_t)n0 * 1024);
        const unsigned char* hbase = (const unsigned char*)(H + (size_t)m0 * 1024);
        auto stage = [&](int buf, int kt) {
#pragma unroll
            for (int i = 0; i < 4; ++i) {
                const int p = wave + 8 * i;
                __builtin_amdgcn_global_load_lds((const unsigned*)(wbase + kt * 128 + voff[i]), (__attribute__((address_space(3))) unsigned*)(lds + buf * 65536 + p * 1024), 16, 0, 0);
                __builtin_amdgcn_global_load_lds((const unsigned*)(hbase + kt * 128 + voff[i]), (__attribute__((address_space(3))) unsigned*)(lds + buf * 65536 + 32768 + p * 1024), 16, 0, 0);
            }
        };
        __syncthreads();
        stage(0, 0);
        __syncthreads();
        for (int kt = 0; kt < 16; ++kt) {
            if (kt + 1 < 16) stage((kt + 1) & 1, kt + 1);
            const unsigned char* base = lds + (kt & 1) * 65536;
#define G1_RA(dst, ksv) do { _Pragma("unroll") for (int i = 0; i < 4; ++i) dst[i] = *(const bf16x8*)(base + ((ksv) ? cA1 : cA0) + i * 2048); } while (0)
#define G1_RB(dst, ksv, jh) do { _Pragma("unroll") for (int j = 0; j < 4; ++j) dst[j] = *(const bf16x8*)(base + ((ksv) ? cB1 : cB0) + (4 * (jh) + j) * 2048); } while (0)
#define G1_MM(av, bv, jh) do { _Pragma("unroll") for (int i = 0; i < 4; ++i) _Pragma("unroll") for (int j = 0; j < 4; ++j) \
                acc[i][4 * (jh) + j] = __builtin_amdgcn_mfma_f32_16x16x32_bf16(av[i], bv[j], acc[i][4 * (jh) + j], 0, 0, 0); } while (0)
            {
                bf16x8 aX[4], aY[4], bX[4], bY[4];
                G1_RA(aX, 0); G1_RB(bX, 0, 0);
                __builtin_amdgcn_sched_barrier(0);
                G1_RB(bY, 0, 1); G1_MM(aX, bX, 0);
                __builtin_amdgcn_sched_barrier(0);
                G1_RA(aY, 1); G1_RB(bX, 1, 0); G1_MM(aX, bY, 1);
                __builtin_amdgcn_sched_barrier(0);
                G1_RB(bY, 1, 1); G1_MM(aY, bX, 0);
                __builtin_amdgcn_sched_barrier(0);
                G1_MM(aY, bY, 1);
            }
#undef G1_RA
#undef G1_RB
#undef G1_MM
            __syncthreads();
        }
        const int nb = n0 + wn * 64;
        int le_ = lane; asm volatile("" : "+v"(le_));
        const int l15e = le_ & 15, q4e = le_ >> 4;
#pragma unroll
        for (int b = 0; b < 8; ++b) {
            const int m = m0 + wm * 128 + b * 16 + l15e;
            float sc[16];
#pragma unroll
            for (int e = 0; e < 16; ++e) sc[e] = acc[e >> 2][b][e & 3];
            if (nb >= NP) {
                u32x4 o0, o1;
                o0.x = pack2(sigmoidf_(sc[0]), sigmoidf_(sc[1])); o0.y = pack2(sigmoidf_(sc[2]), sigmoidf_(sc[3]));
                o0.z = pack2(sigmoidf_(sc[4]), sigmoidf_(sc[5])); o0.w = pack2(sigmoidf_(sc[6]), sigmoidf_(sc[7]));
                o1.x = pack2(sigmoidf_(sc[8]), sigmoidf_(sc[9])); o1.y = pack2(sigmoidf_(sc[10]), sigmoidf_(sc[11]));
                o1.z = pack2(sigmoidf_(sc[12]), sigmoidf_(sc[13])); o1.w = pack2(sigmoidf_(sc[14]), sigmoidf_(sc[15]));
                bf16_t* dst = G + (size_t)m * 2048 + (nb - NP) + 16 * q4e;
                *(u32x4*)dst = o0; *(u32x4*)(dst + 8) = o1;
            } else {
                if (nb >= C_Q && nb < C_AV) {
                    float ss = 0.f;
#pragma unroll
                    for (int e = 0; e < 16; ++e) ss += sc[e] * sc[e];
                    ss += __shfl_xor(ss, 16);
                    ss += __shfl_xor(ss, 32);
                    const float rs = rsqrtf(ss * (1.f / 64.f) + 1e-6f) * ((nb < C_AK) ? 0.125f : 1.0f);
                    const float* gain = (nb < C_AK) ? a.q_gain : a.k_gain;
#pragma unroll
                    for (int e = 0; e < 16; ++e) sc[e] = sc[e] * rs * gain[16 * q4e + e];
                }
                if (nb >= C_AK && nb < C_GB) {
                    const int isv = nb >= C_AV;
                    const int head = (nb - (isv ? C_AV : C_AK)) >> 6;
                    unsigned char* rowb = a.ws + WS_KV + (size_t)m * 1024 + (isv ? 8 : 0);
#pragma unroll
                    for (int hf8 = 0; hf8 < 2; ++hf8) {
                        const int u = 8 * (2 * q4e + hf8) + head;
                        unsigned w0 = __builtin_amdgcn_cvt_pk_fp8_f32(sc[8 * hf8 + 0], sc[8 * hf8 + 1], 0, false);
                        w0 = __builtin_amdgcn_cvt_pk_fp8_f32(sc[8 * hf8 + 2], sc[8 * hf8 + 3], w0, true);
                        unsigned w1 = __builtin_amdgcn_cvt_pk_fp8_f32(sc[8 * hf8 + 4], sc[8 * hf8 + 5], 0, false);
                        w1 = __builtin_amdgcn_cvt_pk_fp8_f32(sc[8 * hf8 + 6], sc[8 * hf8 + 7], w1, true);
                        *(u32x2*)(rowb + 16 * u) = (u32x2){w0, w1};
                    }
                } else {
                    u32x4 o0, o1;
                    o0.x = pack2(sc[0], sc[1]); o0.y = pack2(sc[2], sc[3]); o0.z = pack2(sc[4], sc[5]); o0.w = pack2(sc[6], sc[7]);
                    o1.x = pack2(sc[8], sc[9]); o1.y = pack2(sc[10], sc[11]); o1.z = pack2(sc[12], sc[13]); o1.w = pack2(sc[14], sc[15]);
                    bf16_t* dst = P + (size_t)m * NP + nb + 16 * q4e;
                    *(u32x4*)dst = o0; *(u32x4*)(dst + 8) = o1;
                }
            }
        }
    }
}

__device__ __forceinline__ bf16x8 ldfrag(const unsigned char* arr, int row, int ks, int hi) { return *(const bf16x8*)(arr + swz128(row, 2 * ks + hi)); }
__device__ __forceinline__ f32x16 mm_tile(const unsigned char* Aarr, int arow0, const unsigned char* Barr, int brow0, int l31, int hi, f32x16 acc) {
#pragma unroll
    for (int ks = 0; ks < 4; ++ks) acc = __builtin_amdgcn_mfma_f32_32x32x16_bf16(ldfrag(Aarr, arow0 + l31, ks, hi), ldfrag(Barr, brow0 + l31, ks, hi), acc, 0, 0, 0);
    return acc;
}
__device__ __forceinline__ int rowmap(int r, int hi) { return (r & 3) + 8 * (r >> 2) + 4 * hi; }
__device__ __forceinline__ void store_lane_major(unsigned char* arr, const f32x16& acc, int irow0, int t, int hi, int incl) {
#pragma unroll
    for (int q = 0; q < 4; ++q) {
        float v[4];
#pragma unroll
        for (int e = 0; e < 4; ++e) { const int i = irow0 + 8 * q + 4 * hi + e; v[e] = (i < t + incl) ? acc[4 * q + e] : 0.f; }
        u32x2 o; o.x = pack2(v[0], v[1]); o.y = pack2(v[2], v[3]);
        *(u32x2*)(arr + swz128(t, (irow0 >> 3) + q) + 8 * hi) = o;
    }
}
__device__ __forceinline__ void load_shift16(const bf16_t* P, int tglob, int col, const float* mu, float (&out)[16]) {
    const bf16_t* pc = P + (size_t)tglob * NP + col;
    const u32x4 c0 = *(const u32x4*)pc, c1 = *(const u32x4*)(pc + 8);
    u32x4 p0 = (u32x4){0u, 0u, 0u, 0u}, p1 = p0;
    if (tglob > 0) { p0 = *(const u32x4*)(pc - NP); p1 = *(const u32x4*)(pc - NP + 8); }
    const unsigned cw[8] = {c0.x, c0.y, c0.z, c0.w, c1.x, c1.y, c1.z, c1.w};
    const unsigned pw[8] = {p0.x, p0.y, p0.z, p0.w, p1.x, p1.y, p1.z, p1.w};
#pragma unroll
    for (int e = 0; e < 8; ++e) {
        const float ca = lo2f(cw[e]), cb = hi2f(cw[e]), pa = lo2f(pw[e]), pb = hi2f(pw[e]);
        out[2 * e] = ca + mu[col + 2 * e] * (pa - ca);
        out[2 * e + 1] = cb + mu[col + 2 * e + 1] * (pb - cb);
    }
}
__device__ __forceinline__ void half_solve(const float* NBT, int base, float (&x)[32]) {
#pragma unroll
    for (int i = 0; i < 31; ++i) {
        const float xi = x[i];
        int z; asm("v_mov_b32 %0, 0 ; after %1" : "=v"(z) : "v"(x[i > 3 ? i - 4 : 0]));
        const float* ncol = NBT + (base + i) * 64 + base + z;
#pragma unroll
        for (int g4 = (i + 1) / 4; g4 < 8; ++g4) {
            const f32x4 n = *(const f32x4*)(ncol + 4 * g4);
            if (4 * g4 + 0 > i) x[4 * g4 + 0] += n.x * xi;
            if (4 * g4 + 1 > i) x[4 * g4 + 1] += n.y * xi;
            if (4 * g4 + 2 > i) x[4 * g4 + 2] += n.z * xi;
            if (4 * g4 + 3 > i) x[4 * g4 + 3] += n.w * xi;
        }
    }
}
__device__ __forceinline__ void tri_solve(const float* NBT, unsigned char* rhs, unsigned char* outT, unsigned char* nsw, bf16_t* gp) {
    int t_ = threadIdx.x; asm volatile("" : "+v"(t_));
    const int lane = t_ & 63, l31 = lane & 31, hi = lane >> 5;
    {
        float v[16];
#pragma unroll
        for (int e = 0; e < 16; ++e) v[e] = NBT[(16 * hi + e) * 64 + 32 + l31];
        u32x4 o0, o1;
        o0.x = pack2(v[0], v[1]); o0.y = pack2(v[2], v[3]); o0.z = pack2(v[4], v[5]); o0.w = pack2(v[6], v[7]);
        o1.x = pack2(v[8], v[9]); o1.y = pack2(v[10], v[11]); o1.z = pack2(v[12], v[13]); o1.w = pack2(v[14], v[15]);
        *(u32x4*)(nsw + l31 * 64 + hi * 32) = o0; *(u32x4*)(nsw + l31 * 64 + hi * 32 + 16) = o1;
    }
    float x[32];
#pragma unroll
    for (int t = 0; t < 32; ++t) x[t] = bf2f(*(const bf16_t*)(rhs + (t * 64 + lane) * 2));
    half_solve(NBT, 0, x);
#pragma unroll
    for (int c = 0; c < 4; ++c) {
        u32x4 o; o.x = pack2(x[8 * c], x[8 * c + 1]); o.y = pack2(x[8 * c + 2], x[8 * c + 3]); o.z = pack2(x[8 * c + 4], x[8 * c + 5]); o.w = pack2(x[8 * c + 6], x[8 * c + 7]);
        *(u32x4*)(outT + swz128(lane, c)) = o;
    }
#pragma unroll
    for (int t = 0; t < 32; ++t) gp[(size_t)t * NP + lane] = f2bf(x[t]);
    wave_lds_sync();
#pragma unroll
    for (int tile = 0; tile < 2; ++tile) {
        f32x16 acc = zero16();
#pragma unroll
        for (int ks = 0; ks < 2; ++ks)
            acc = __builtin_amdgcn_mfma_f32_32x32x16_bf16(*(const bf16x8*)(nsw + l31 * 64 + (2 * ks + hi) * 16), ldfrag(outT, 32 * tile + l31, ks, hi), acc, 0, 0, 0);
#pragma unroll
        for (int r = 0; r < 16; ++r) {
            bf16_t* p = (bf16_t*)(rhs + ((32 + rowmap(r, hi)) * 64 + 32 * tile + l31) * 2);
            *p = f2bf(bf2f(*p) + acc[r]);
        }
    }
    wave_lds_sync();
#pragma unroll
    for (int t = 0; t < 32; ++t) x[t] = bf2f(*(const bf16_t*)(rhs + ((32 + t) * 64 + lane) * 2));
    half_solve(NBT, 32, x);
#pragma unroll
    for (int c = 0; c < 4; ++c) {
        u32x4 o; o.x = pack2(x[8 * c], x[8 * c + 1]); o.y = pack2(x[8 * c + 2], x[8 * c + 3]); o.z = pack2(x[8 * c + 4], x[8 * c + 5]); o.w = pack2(x[8 * c + 6], x[8 * c + 7]);
        *(u32x4*)(outT + swz128(lane, 4 + c)) = o;
    }
#pragma unroll
    for (int t = 0; t < 32; ++t) gp[(size_t)(32 + t) * NP + lane] = f2bf(x[t]);
}

constexpr int RO_AT = 0, RO_RT = 8192  , RO_KT = 16384, RO_BT = 24576, RO_VT = 32768, RO_ST = 40960  ;
constexpr int RO_NB = 16384;
constexpr int RO_AAK = 49152;
constexpr int RO_X1 = 57344  , RO_WTT = 49152  , RO_U0T = 73728;
constexpr int RO_NSW = 0;
constexpr int RO_ARB = 57344, RO_ARK = 16384  , RO_WP = 0  , RO_U0P = 65536  ;
constexpr int RO_UT = 49152;
constexpr int RO_Y = 16384;
constexpr int RO_TW = 0, RO_TA = 8192, RO_WL = 16384, RO_AL = 32768, RO_LWL = 49152, RO_QT = 73728, RO_APL = 65536  ;

template <int PASS>
__device__ __forceinline__ void phase_rwkv_chunk(const Args& a, unsigned char* lds, int wg, int nwg) {
    for (int chunk = wg; chunk < 256; chunk += nwg) {
#pragma unroll 1
        for (int rd = 0; rd < 4; ++rd) {
            unsigned char* wsb = a.ws; asm volatile("" : "+s"(wsb));
            const bf16_t* P = (const bf16_t*)(wsb + WS_P);
            const bf16_t* WupT = (const bf16_t*)(wsb + WS_WUPT);
            const bf16_t* AupT = (const bf16_t*)(wsb + WS_AUPT);
            float* GLg = (float*)(wsb + WS_GL);
            unsigned char* RMg = wsb + WS_RM;
            unsigned char* RCg = wsb + WS_RC;
            bf16_t* YA = (bf16_t*)(wsb + WS_YA);
            int tid = threadIdx.x; asm volatile("" : "+v"(tid));
            const int wv = __builtin_amdgcn_readfirstlane((int)(threadIdx.x >> 6));
            const int g = wv >> 2, w4 = wv & 3, lt = tid & 255, lane = tid & 63, l31 = lane & 31, hi = lane >> 5;
            unsigned char* R = lds + g * 81920;
            const int et = lt >> 2, ec0 = 16 * (lt & 3);
            const int ta = w4 >> 1, tb = w4 & 1;
            const int h = 2 * rd + g, t0 = chunk * 64, colh = 64 * h, item = chunk * 8 + h;
            __syncthreads();
            float k_s[16];
            load_shift16(P, t0 + et, C_K + colh + ec0, a.mu, k_s);
            {
                float tmp[16];
                load_shift16(P, t0 + et, C_WD + ec0, a.mu, tmp);
                u32x4 o0, o1;
                o0.x = pack2(tanhf_(tmp[0]), tanhf_(tmp[1])); o0.y = pack2(tanhf_(tmp[2]), tanhf_(tmp[3])); o0.z = pack2(tanhf_(tmp[4]), tanhf_(tmp[5])); o0.w = pack2(tanhf_(tmp[6]), tanhf_(tmp[7]));
                o1.x = pack2(tanhf_(tmp[8]), tanhf_(tmp[9])); o1.y = pack2(tanhf_(tmp[10]), tanhf_(tmp[11])); o1.z = pack2(tanhf_(tmp[12]), tanhf_(tmp[13])); o1.w = pack2(tanhf_(tmp[14]), tanhf_(tmp[15]));
                *(u32x4*)(R + RO_TW + swz128(et, ec0 >> 3)) = o0; *(u32x4*)(R + RO_TW + swz128(et, (ec0 >> 3) + 1)) = o1;
                load_shift16(P, t0 + et, C_AD + ec0, a.mu, tmp);
                o0.x = pack2(tmp[0], tmp[1]); o0.y = pack2(tmp[2], tmp[3]); o0.z = pack2(tmp[4], tmp[5]); o0.w = pack2(tmp[6], tmp[7]);
                o1.x = pack2(tmp[8], tmp[9]); o1.y = pack2(tmp[10], tmp[11]); o1.z = pack2(tmp[12], tmp[13]); o1.w = pack2(tmp[14], tmp[15]);
                *(u32x4*)(R + RO_TA + swz128(et, ec0 >> 3)) = o0; *(u32x4*)(R + RO_TA + swz128(et, (ec0 >> 3) + 1)) = o1;
            }
            __syncthreads();
            {
                f32x16 accw = zero16(), acca = zero16();
                const bf16_t* wp = WupT + (size_t)(colh + 32 * tb + l31) * 64 + 8 * hi;
                const bf16_t* ap = AupT + (size_t)(colh + 32 * tb + l31) * 64 + 8 * hi;
#pragma unroll
                for (int ks = 0; ks < 4; ++ks) {
                    accw = __builtin_amdgcn_mfma_f32_32x32x16_bf16(ldfrag(R + RO_TW, 32 * ta + l31, ks, hi), *(const bf16x8*)(wp + 16 * ks), accw, 0, 0, 0);
                    acca = __builtin_amdgcn_mfma_f32_32x32x16_bf16(ldfrag(R + RO_TA, 32 * ta + l31, ks, hi), *(const bf16x8*)(ap + 16 * ks), acca, 0, 0, 0);
                }
                float* WL = (float*)(R + RO_WL); float* AL = (float*)(R + RO_AL);
#pragma unroll
                for (int r = 0; r < 16; ++r) { const int t = 32 * ta + rowmap(r, hi); WL[t * 64 + 32 * tb + l31] = accw[r]; AL[t * 64 + 32 * tb + l31] = acca[r]; }
            }
            __syncthreads();
            float lw[16], kk[16], av[16], kbar[16];
            float bonus = 0.f;
            {
                float r_s[16];
                if (PASS == 2) load_shift16(P, t0 + et, C_R + colh + ec0, a.mu, r_s);
                const float* WL = (const float*)(R + RO_WL); const float* AL = (const float*)(R + RO_AL);
                float ss = 0.f;
#pragma unroll
                for (int e = 0; e < 16; ++e) {
                    const int c = colh + ec0 + e;
                    const float wl = WL[et * 64 + ec0 + e], al = AL[et * 64 + ec0 + e];
                    lw[e] = -0.606531f / (1.f + __expf(-(a.w0[c] + wl)));
                    av[e] = 1.f / (1.f + __expf(-(a.a0[c] + al)));
                    kk[e] = k_s[e] * a.k_k[c];
                    ss += kk[e] * kk[e];
                    kbar[e] = k_s[e] * (1.f + (av[e] - 1.f) * a.k_a[c]);
                    if (PASS == 2) bonus += r_s[e] * kbar[e] * a.r_k[c];
                }
                ss = sum4_dpp(ss);
                if (PASS == 2) bonus = sum4_dpp(bonus);
                const float inv = 1.f / fmaxf(sqrtf(ss), 1e-12f);
                float* LWL = (float*)(R + RO_LWL);
#pragma unroll
                for (int e = 0; e < 16; ++e) { kk[e] *= inv; LWL[et * 64 + ec0 + e] = lw[e]; }
            }
            __syncthreads();
            {
                float* LWL = (float*)(R + RO_LWL); float* QT = (float*)(R + RO_QT);
                const int col = lt & 63, qtr = lt >> 6;
                float s = 0.f;
#pragma unroll
                for (int i = 0; i < 16; ++i) { s += LWL[(16 * qtr + i) * 64 + col]; LWL[(16 * qtr + i) * 64 + col] = s; }
                QT[qtr * 64 + col] = s;
            }
            __syncthreads();
            {
                const float* LWL = (const float*)(R + RO_LWL); const float* QT = (const float*)(R + RO_QT);
                const int qtr = et >> 4;
                float r_s[16], v_s[16];
                load_shift16(P, t0 + et, C_V + colh + ec0, a.mu, v_s);
                if (PASS == 2) load_shift16(P, t0 + et, C_R + colh + ec0, a.mu, r_s);
#pragma unroll
                for (int hlf = 0; hlf < 2; ++hlf) {
                    float at_[8], kt_[8], bt_[8], rt_[8];
#pragma unroll
                    for (int e8 = 0; e8 < 8; ++e8) {
                        const int e = 8 * hlf + e8, col = ec0 + e;
                        const float q0 = QT[col], q1 = QT[64 + col], q2 = QT[128 + col], q3 = QT[192 + col];
                        const float off = (qtr > 0 ? q0 : 0.f) + (qtr > 1 ? q1 : 0.f) + (qtr > 2 ? q2 : 0.f);
                        const float Lt = LWL[et * 64 + col] + off, Lend = (q0 + q1) + (q2 + q3);
                        const float ep = __expf(Lt), em = __expf(-Lt), epv = __expf(Lt - lw[e]), eend = __expf(Lend - Lt);
                        at_[e8] = -kk[e] * epv; kt_[e8] = kbar[e] * em; bt_[e8] = kk[e] * av[e] * em; rt_[e8] = r_s[e] * ep;
                        const int toff = swz128(col, et >> 3) + (et & 7) * 2;
                        *(bf16_t*)(R + RO_VT + toff) = f2bf(v_s[e]);
                        if (PASS == 1) {
                            *(bf16_t*)(R + RO_RT + toff) = f2bf(kk[e] * av[e] * eend);
                            *(bf16_t*)(R + RO_ST + toff) = f2bf(kbar[e] * eend);
                            if (et == 63) GLg[(size_t)item * 64 + col] = __expf(Lend);
                        }
                    }
                    u32x4 o;
                    const int ch = (ec0 >> 3) + hlf;
                    o.x = pack2(at_[0], at_[1]); o.y = pack2(at_[2], at_[3]); o.z = pack2(at_[4], at_[5]); o.w = pack2(at_[6], at_[7]);
                    if (PASS == 1) { *(u32x4*)(R + RO_AT + swz128(et, ch)) = o; *(u32x4*)(R + RO_APL + (et * 64 + ec0 + 8 * hlf) * 2) = o; }
                    o.x = pack2(kt_[0], kt_[1]); o.y = pack2(kt_[2], kt_[3]); o.z = pack2(kt_[4], kt_[5]); o.w = pack2(kt_[6], kt_[7]);
                    *(u32x4*)(R + RO_KT + swz128(et, ch)) = o;
                    o.x = pack2(bt_[0], bt_[1]); o.y = pack2(bt_[2], bt_[3]); o.z = pack2(bt_[4], bt_[5]); o.w = pack2(bt_[6], bt_[7]);
                    *(u32x4*)(R + RO_BT + swz128(et, ch)) = o;
                    if (PASS == 2) {
                        o.x = pack2(rt_[0], rt_[1]); o.y = pack2(rt_[2], rt_[3]); o.z = pack2(rt_[4], rt_[5]); o.w = pack2(rt_[6], rt_[7]);
                        *(u32x4*)(R + RO_RT + swz128(et, ch)) = o;
                    }
                }
                if (PASS == 2) {
#pragma unroll
                    for (int i = 0; i < 2; ++i) {
                        const int cid = lt + 256 * i, row = cid >> 3, kc = cid & 7;
                        u32x4 sv = (u32x4){0u, 0u, 0u, 0u};
                        if (chunk > 0) sv = *(const u32x4*)(RCg + (size_t)(item - 8) * 8192 + row * 128 + kc * 16);
                        *(u32x4*)(R + RO_ST + swz128(row, kc)) = sv;
                        *(u32x4*)(R + RO_WP + swz128(row, kc)) = *(const u32x4*)(P + (size_t)(t0 + row) * NP + C_AK + colh + kc * 8);
                        *(u32x4*)(R + RO_U0P + row * 128 + kc * 16) = *(const u32x4*)(P + (size_t)(t0 + row) * NP + C_AV + colh + kc * 8);
                    }
                }
            }
            __syncthreads();
            {
                f32x16 accN = zero16(), accAak = zero16(), accArb = zero16(), accArk = zero16(), accU = zero16();
                if (ta <= tb) {
                    if (PASS == 1) {
                        accN = mm_tile(R + RO_BT, 32 * ta, R + RO_AT, 32 * tb, l31, hi, accN);
                        accAak = mm_tile(R + RO_KT, 32 * ta, R + RO_AT, 32 * tb, l31, hi, accAak);
                    } else {
                        accArb = mm_tile(R + RO_BT, 32 * ta, R + RO_RT, 32 * tb, l31, hi, accArb);
                        accArk = mm_tile(R + RO_KT, 32 * ta, R + RO_RT, 32 * tb, l31, hi, accArk);
                    }
                }
                if (PASS == 2) accU = mm_tile(R + RO_WP, 32 * ta, R + RO_ST, 32 * tb, l31, hi, accU);
                __syncthreads();
                if (PASS == 1) {
                    float* NB = (float*)(R + RO_NB);
#pragma unroll
                    for (int r = 0; r < 16; ++r) { const int i = 32 * ta + rowmap(r, hi), t = 32 * tb + l31; NB[i * 64 + t] = (i < t) ? accN[r] : 0.f; }
                    store_lane_major(R + RO_AAK, accAak, 32 * ta, 32 * tb + l31, hi, 0);
                } else {
                    store_lane_major(R + RO_ARB, accArb, 32 * ta, 32 * tb + l31, hi, 1);
                    store_lane_major(R + RO_ARK, accArk, 32 * ta, 32 * tb + l31, hi, 1);
#pragma unroll
                    for (int r = 0; r < 16; ++r) accU[r] += bf2f(*(const bf16_t*)(R + RO_U0P + ((32 * ta + rowmap(r, hi)) * 64 + 32 * tb + l31) * 2));
                    store_lane_major(R + RO_UT, accU, 32 * ta, 32 * tb + l31, hi, 64);
                }
            }
            __syncthreads();
            if (PASS == 1) {
                {
                    f32x16 acc = zero16();
                    acc = mm_tile(R + RO_AAK, 32 * ta, R + RO_VT, 32 * tb, l31, hi, acc);
#pragma unroll
                    for (int r = 0; r < 16; ++r) { const int t = 32 * ta + rowmap(r, hi); *(bf16_t*)(R + RO_X1 + (t * 64 + 32 * tb + l31) * 2) = f2bf(acc[r]); }
                }
                __syncthreads();
                if (w4 < 2) tri_solve((const float*)(R + RO_NB), R + (w4 ? RO_X1 : RO_APL), R + (w4 ? RO_U0T : RO_WTT), R + RO_NSW + 2048 * w4,
                                      (bf16_t*)(wsb + WS_P) + (size_t)t0 * NP + (w4 ? C_AV : C_AK) + colh);
                __syncthreads();
                int tid3 = threadIdx.x; asm volatile("" : "+v"(tid3));
                const int lane = tid3 & 63, l31 = lane & 31, hi = lane >> 5;
                {
                    f32x16 acc = zero16();
                    acc = mm_tile(R + RO_WTT, 32 * ta, R + RO_RT, 32 * tb, l31, hi, acc);
                    if (ta == tb) {
                        const float g63 = GLg[(size_t)item * 64 + 32 * tb + l31];
#pragma unroll
                        for (int r = 0; r < 16; ++r) if (rowmap(r, hi) == l31) acc[r] += g63;
                    }
                    unsigned char* mp = RMg + (size_t)item * 8192 + ((size_t)((tb * 2 + ta) * 2) * 64 + lane) * 16;
                    u32x4 o;
                    o.x = pack2(acc[0], acc[1]); o.y = pack2(acc[2], acc[3]); o.z = pack2(acc[4], acc[5]); o.w = pack2(acc[6], acc[7]);
                    *(u32x4*)mp = o;
                    o.x = pack2(acc[8], acc[9]); o.y = pack2(acc[10], acc[11]); o.z = pack2(acc[12], acc[13]); o.w = pack2(acc[14], acc[15]);
                    *(u32x4*)(mp + 64 * 16) = o;
                }
                {
                    f32x16 acc = zero16();
                    acc = mm_tile(R + RO_RT, 32 * ta, R + RO_U0T, 32 * tb, l31, hi, acc);
                    acc = mm_tile(R + RO_ST, 32 * ta, R + RO_VT, 32 * tb, l31, hi, acc);
                    unsigned char* cp = RCg + (size_t)item * 8192 + ((size_t)(tb * 2 + ta) * 64 + lane) * 32;
                    u32x4 o;
                    o.x = pack2(acc[0], acc[1]); o.y = pack2(acc[2], acc[3]); o.z = pack2(acc[4], acc[5]); o.w = pack2(acc[6], acc[7]);
                    *(u32x4*)cp = o;
                    o.x = pack2(acc[8], acc[9]); o.y = pack2(acc[10], acc[11]); o.z = pack2(acc[12], acc[13]); o.w = pack2(acc[14], acc[15]);
                    *(u32x4*)(cp + 16) = o;
                }
            } else {
                int tid2 = threadIdx.x; asm volatile("" : "+v"(tid2));
                const int lane = tid2 & 63, l31 = lane & 31, hi = lane >> 5, lt = tid2 & 255, et = lt >> 2, ec0 = 16 * (lt & 3);
                {
                    f32x16 acc = zero16();
                    acc = mm_tile(R + RO_RT, 32 * ta, R + RO_ST, 32 * tb, l31, hi, acc);
                    acc = mm_tile(R + RO_ARB, 32 * ta, R + RO_UT, 32 * tb, l31, hi, acc);
                    acc = mm_tile(R + RO_ARK, 32 * ta, R + RO_VT, 32 * tb, l31, hi, acc);
                    __syncthreads();
                    float* Y = (float*)(R + RO_Y);
#pragma unroll
                    for (int r = 0; r < 16; ++r) { const int t = 32 * ta + rowmap(r, hi); Y[t * 64 + 32 * tb + l31] = acc[r]; }
                }
                __syncthreads();
                {
                    const float* Y = (const float*)(R + RO_Y);
                    float g_s[16], v_e[16];
                    load_shift16(P, t0 + et, C_G + colh + ec0, a.mu, g_s);
                    load_shift16(P, t0 + et, C_V + colh + ec0, a.mu, v_e);
                    float y[16], s = 0.f;
#pragma unroll
                    for (int e = 0; e < 16; ++e) { y[e] = Y[et * 64 + ec0 + e]; s += y[e]; }
                    s = sum4_dpp(s);
                    const float mean = s * (1.f / 64.f);
                    float q = 0.f;
#pragma unroll
                    for (int e = 0; e < 16; ++e) { const float d = y[e] - mean; q += d * d; }
                    q = sum4_dpp(q);
                    const float rstd = rsqrtf(q * (1.f / 64.f) + 64e-5f);
                    float o[16];
#pragma unroll
                    for (int e = 0; e < 16; ++e) {
                        const int c = colh + ec0 + e;
                        const float yn = (y[e] - mean) * rstd * a.gn_w[c] + a.gn_b[c];
                        o[e] = (yn + bonus * v_e[e]) * (g_s[e] / (1.f + __expf(-g_s[e])));
                    }
                    u32x4 o0, o1;
                    o0.x = pack2(o[0], o[1]); o0.y = pack2(o[2], o[3]); o0.z = pack2(o[4], o[5]); o0.w = pack2(o[6], o[7]);
                    o1.x = pack2(o[8], o[9]); o1.y = pack2(o[10], o[11]); o1.z = pack2(o[12], o[13]); o1.w = pack2(o[14], o[15]);
                    bf16_t* dst = YA + (size_t)(t0 + et) * 512 + colh + ec0;
                    *(u32x4*)dst = o0; *(u32x4*)(dst + 8) = o1;
                }
            }
        }
    }
}

struct ScanBuf { u32x4 m[8], c[4]; };
__device__ __forceinline__ void scan_prefetch(ScanBuf& b, const unsigned char* RMg, const unsigned char* RCg, int c, int h, int vh, int lane) {
    const int item = (c < 256 ? c : 255) * 8 + h;
    const unsigned char* mp = RMg + (size_t)item * 8192 + (size_t)lane * 16;
#pragma unroll
    for (int i = 0; i < 8; ++i) b.m[i] = *(const u32x4*)(mp + (size_t)i * 64 * 16);
#pragma unroll
    for (int kt = 0; kt < 2; ++kt) {
        const unsigned char* cp = RCg + (size_t)item * 8192 + ((size_t)(vh * 2 + kt) * 64 + lane) * 32;
        b.c[2 * kt] = *(const u32x4*)cp; b.c[2 * kt + 1] = *(const u32x4*)(cp + 16);
    }
}
__device__ __forceinline__ void scan_step(const ScanBuf& b, f32x16 (&X)[2], unsigned char* RCg, int c, int h, int vh, int l31, int hi) {
    bf16x8 bfr[2][2];
#pragma unroll
    for (int kt = 0; kt < 2; ++kt)
#pragma unroll
        for (int s = 0; s < 2; ++s) {
            u32x4 w;
            w.x = pack2(X[kt][8 * s + 0], X[kt][8 * s + 1]); w.y = pack2(X[kt][8 * s + 2], X[kt][8 * s + 3]);
            w.z = pack2(X[kt][8 * s + 4], X[kt][8 * s + 5]); w.w = pack2(X[kt][8 * s + 6], X[kt][8 * s + 7]);
            bfr[kt][s] = __builtin_bit_cast(bf16x8, w);
        }
#pragma unroll
    for (int kp = 0; kp < 2; ++kp) {
        f32x16 acc;
        const unsigned cw[8] = {b.c[2 * kp].x, b.c[2 * kp].y, b.c[2 * kp].z, b.c[2 * kp].w, b.c[2 * kp + 1].x, b.c[2 * kp + 1].y, b.c[2 * kp + 1].z, b.c[2 * kp + 1].w};
#pragma unroll
        for (int e = 0; e < 8; ++e) { acc[2 * e] = lo2f(cw[e]); acc[2 * e + 1] = hi2f(cw[e]); }
#pragma unroll
        for (int kt = 0; kt < 2; ++kt)
#pragma unroll
            for (int s = 0; s < 2; ++s) acc = __builtin_amdgcn_mfma_f32_32x32x16_bf16(__builtin_bit_cast(bf16x8, b.m[(kp * 2 + kt) * 2 + s]), bfr[kt][s], acc, 0, 0, 0);
        X[kp] = acc;
    }
    unsigned char* sp = RCg + (size_t)(c * 8 + h) * 8192 + (size_t)(32 * vh + l31) * 128;
#pragma unroll
    for (int kp = 0; kp < 2; ++kp)
#pragma unroll
        for (int q = 0; q < 4; ++q) {
            u32x2 o; o.x = pack2(X[kp][4 * q], X[kp][4 * q + 1]); o.y = pack2(X[kp][4 * q + 2], X[kp][4 * q + 3]);
            *(u32x2*)(sp + (32 * kp + 8 * q + 4 * hi) * 2) = o;
        }
}
__device__ __forceinline__ void phase_rwkv_scan(const Args& a, int wg) {
    if (wg >= 8 || threadIdx.x >= 128) return;
    int lane_ = threadIdx.x; asm volatile("" : "+v"(lane_));
    const int h = wg, vh = __builtin_amdgcn_readfirstlane(lane_ >> 6), lane = lane_ & 63, l31 = lane & 31, hi = lane >> 5;
    const unsigned char* RMg = a.ws + WS_RM;
    unsigned char* RCg = a.ws + WS_RC;
    f32x16 X[2] = {zero16(), zero16()};
    ScanBuf b0, b1, b2;
    scan_prefetch(b0, RMg, RCg, 0, h, vh, lane);
    scan_prefetch(b1, RMg, RCg, 1, h, vh, lane);
    scan_prefetch(b2, RMg, RCg, 2, h, vh, lane);
    for (int c = 0; c < 255; c += 3) {
        scan_step(b0, X, RCg, c, h, vh, l31, hi);     scan_prefetch(b0, RMg, RCg, c + 3, h, vh, lane);
        scan_step(b1, X, RCg, c + 1, h, vh, l31, hi); scan_prefetch(b1, RMg, RCg, c + 4, h, vh, lane);
        scan_step(b2, X, RCg, c + 2, h, vh, l31, hi); scan_prefetch(b2, RMg, RCg, c + 5, h, vh, lane);
    }
    scan_step(b0, X, RCg, 255, h, vh, l31, hi);
}

__device__ __forceinline__ float max8_dpp(float v) { v = fmaxf(v, dppf<0xB1>(v)); v = fmaxf(v, dppf<0x4E>(v)); v = fmaxf(v, dppf<0x141>(v)); return v; }

__device__ __forceinline__ void attn_query(const bf16_t* P, const unsigned char* KV, bf16_t* YB, int t, int cnt, const unsigned short* sl, float* rw, int lane) {
    const int h = lane & 7, j = lane >> 3;
    {
        const int per = cnt >> 3;
        f32x2 q2[32];
        {
            const float L2E = 1.44269504089f;
#pragma unroll
            for (int c = 0; c < 8; ++c) {
                const u32x4 qr = *(const u32x4*)(P + (size_t)t * NP + C_Q + 64 * h + 8 * c);
                q2[4 * c + 0] = (f32x2){lo2f(qr.x) * L2E, hi2f(qr.x) * L2E}; q2[4 * c + 1] = (f32x2){lo2f(qr.y) * L2E, hi2f(qr.y) * L2E};
                q2[4 * c + 2] = (f32x2){lo2f(qr.z) * L2E, hi2f(qr.z) * L2E}; q2[4 * c + 3] = (f32x2){lo2f(qr.w) * L2E, hi2f(qr.w) * L2E};
            }
        }
        const unsigned short* myk = sl + j * per;
        float m = -INFINITY, l = 0.f;
        f32x2 acc[32];
#pragma unroll
        for (int d = 0; d < 32; ++d) acc[d] = (f32x2){0.f, 0.f};
        const unsigned char* kvb = KV + 16 * h;
        u32x4 kA[8], kB[8];
#define AT_LOAD(dst, keyv) do { const unsigned char* p_ = kvb + (size_t)(keyv) * 1024; _Pragma("unroll") for (int i = 0; i < 8; ++i) \
            asm volatile("global_load_dwordx4 %0, %1, off offset:%2" : "=v"(dst[i]) : "v"(p_), "n"(128 * i) : "memory"); } while (0)
#define AT_WAIT(dst) asm volatile("s_waitcnt vmcnt(8)" : "+v"(dst[0]), "+v"(dst[1]), "+v"(dst[2]), "+v"(dst[3]), "+v"(dst[4]), "+v"(dst[5]), "+v"(dst[6]), "+v"(dst[7]) :: "memory")
#define AT_STEP(kv) do { \
            f32x2 d0 = (f32x2){0.f, 0.f}, d1 = (f32x2){0.f, 0.f}; \
            _Pragma("unroll") for (int i = 0; i < 8; ++i) { \
                d0 = q2[4 * i + 0] * __builtin_amdgcn_cvt_pk_f32_fp8(kv[i].x, false) + d0; d1 = q2[4 * i + 1] * __builtin_amdgcn_cvt_pk_f32_fp8(kv[i].x, true) + d1; \
                d0 = q2[4 * i + 2] * __builtin_amdgcn_cvt_pk_f32_fp8(kv[i].y, false) + d0; d1 = q2[4 * i + 3] * __builtin_amdgcn_cvt_pk_f32_fp8(kv[i].y, true) + d1; } \
            const float dot = (d0.x + d0.y) + (d1.x + d1.y); \
            if (dot > m + 8.f) {              \
                const float scl = __builtin_amdgcn_exp2f(m - dot); l *= scl; \
                _Pragma("unroll") for (int d = 0; d < 32; ++d) acc[d] = acc[d] * scl; \
                m = dot; } \
            const float p = __builtin_amdgcn_exp2f(dot - m); l += p; \
            const f32x2 pp = (f32x2){p, p}; \
            _Pragma("unroll") for (int i = 0; i < 8; ++i) { \
                acc[4 * i + 0] = __builtin_amdgcn_cvt_pk_f32_fp8(kv[i].z, false) * pp + acc[4 * i + 0]; acc[4 * i + 1] = __builtin_amdgcn_cvt_pk_f32_fp8(kv[i].z, true) * pp + acc[4 * i + 1]; \
                acc[4 * i + 2] = __builtin_amdgcn_cvt_pk_f32_fp8(kv[i].w, false) * pp + acc[4 * i + 2]; acc[4 * i + 3] = __builtin_amdgcn_cvt_pk_f32_fp8(kv[i].w, true) * pp + acc[4 * i + 3]; } } while (0)
        unsigned k1 = myk[1];
        AT_LOAD(kA, (unsigned)myk[0]);
#pragma unroll 1
        for (int s = 0; s < per; s += 2) {
            const int s2 = s + 2 < per ? s + 2 : per - 1, s3 = s + 3 < per ? s + 3 : per - 1;
            const unsigned kn0 = myk[s2], kn1 = myk[s3];
            AT_LOAD(kB, k1);  AT_WAIT(kA); AT_STEP(kA);
            AT_LOAD(kA, kn0); AT_WAIT(kB); AT_STEP(kB);
            k1 = kn1;
        }
        asm volatile("s_waitcnt vmcnt(0)" : "+v"(kA[0]), "+v"(kA[1]), "+v"(kA[2]), "+v"(kA[3]), "+v"(kA[4]), "+v"(kA[5]), "+v"(kA[6]), "+v"(kA[7]) :: "memory");
#undef AT_LOAD
#undef AT_WAIT
#undef AT_STEP
        float ms = m; ms = fmaxf(ms, __shfl_xor(ms, 8)); ms = fmaxf(ms, __shfl_xor(ms, 16)); ms = fmaxf(ms, __shfl_xor(ms, 32));
        const float f = __builtin_amdgcn_exp2f(m - ms);
        float ls = l * f; ls += __shfl_xor(ls, 8); ls += __shfl_xor(ls, 16); ls += __shfl_xor(ls, 32);
        const float inv = 1.f / ls;
        float o[8];
#pragma unroll
        for (int e = 0; e < 8; ++e) o[e] = 0.f;
#pragma unroll
        for (int hf = 0; hf < 2; ++hf) {
            float* myrow = rw + lane * 36;
#pragma unroll
            for (int c = 0; c < 8; ++c) *(f32x4*)(myrow + 4 * c) = (f32x4){acc[16 * hf + 2 * c].x * f, acc[16 * hf + 2 * c].y * f, acc[16 * hf + 2 * c + 1].x * f, acc[16 * hf + 2 * c + 1].y * f};
            if ((j >> 2) == hf) {
#pragma unroll
                for (int jj = 0; jj < 8; ++jj) {
                    const float* r = rw + (8 * jj + h) * 36 + 8 * (j & 3);
                    const f32x4 a0 = *(const f32x4*)r, a1 = *(const f32x4*)(r + 4);
                    o[0] += a0.x; o[1] += a0.y; o[2] += a0.z; o[3] += a0.w; o[4] += a1.x; o[5] += a1.y; o[6] += a1.z; o[7] += a1.w;
                }
            }
        }
        const u32x4 graw = *(const u32x4*)(P + (size_t)t * NP + C_GB + 64 * h + 8 * j);
        const float gg[8] = {lo2f(graw.x), hi2f(graw.x), lo2f(graw.y), hi2f(graw.y), lo2f(graw.z), hi2f(graw.z), lo2f(graw.w), hi2f(graw.w)};
#pragma unroll
        for (int e = 0; e < 8; ++e) o[e] = o[e] * inv * (gg[e] / (1.f + __expf(-gg[e])));
        u32x4 ov; ov.x = pack2(o[0], o[1]); ov.y = pack2(o[2], o[3]); ov.z = pack2(o[4], o[5]); ov.w = pack2(o[6], o[7]);
        *(u32x4*)(YB + (size_t)t * 512 + 64 * h + 8 * j) = ov;
    }
}

constexpr int TK_CAP = 640, TK_NE = TK_CAP / 64, TK_RS = 96;
constexpr int TKO_CI = 32 * TK_CAP * 4 + 256, TKO_IKB = TKO_CI + 32 * TK_CAP * 2 + 128, TKO_HIST = TKO_IKB + 32768, TKO_FLAG = TKO_HIST + 4096;
static_assert(TKO_FLAG + 32 <= LDS_BYTES && (TKO_IKB % 16) == 0, "topk LDS map");
struct SelOut { unsigned thr, cgt; };
__device__ __forceinline__ unsigned wave_excl_scan(unsigned v, int lane, unsigned& total) {
    const unsigned incl = wave_incl_scan_dpp(v);
    total = (unsigned)__builtin_amdgcn_readlane((int)incl, 63);
    return incl - v;
}
template <bool EXACT>
__device__ __forceinline__ SelOut wave_select(const unsigned (&u)[TK_NE], const bool (&valid)[TK_NE], unsigned nvalid, unsigned* hist, int lane, unsigned R, unsigned slack) {
    unsigned an = 0xffffffffu, orr = 0u;
#pragma unroll
    for (int i = 0; i < TK_NE; ++i) if (valid[i]) { an &= u[i]; orr |= u[i]; }
    an = ~wave_or_dpp(~an); orr = wave_or_dpp(orr);
    SelOut o;
    const unsigned diff = an ^ orr;
    if (diff == 0u) { o.thr = an; o.cgt = 0u; return o; }
    int bits_left = 32 - __builtin_clz(diff);
    unsigned prefix = (bits_left == 32) ? 0u : ((an >> bits_left) << bits_left);
    unsigned rrem = R, m = nvalid;
#pragma unroll 1
    while (bits_left > 0) {
        const int w = bits_left < 8 ? bits_left : 8, shift = bits_left - w;
        *(u32x2*)(hist + 2 * lane) = (u32x2){0u, 0u};
        wave_lds_sync();
#pragma unroll
        for (int i = 0; i < TK_NE; ++i) {
            const bool act = valid[i] && (bits_left == 32 || ((u[i] ^ prefix) >> bits_left) == 0u);
            const unsigned d = (u[i] >> shift) & ((1u << w) - 1u);
            if (act) atomicAdd(hist + (d >> 1), (d & 1u) ? 0x10000u : 1u);
        }
        wave_lds_sync();
        const u32x2 hw = *(const u32x2*)(hist + 2 * lane);
        const unsigned bb[4] = {hw.x & 0xffffu, hw.x >> 16, hw.y & 0xffffu, hw.y >> 16};
        const unsigned hcnt = (bb[0] + bb[1]) + (bb[2] + bb[3]);
        const unsigned pincl = wave_incl_scan_dpp(hcnt);
        const unsigned ptot = (unsigned)__builtin_amdgcn_readlane((int)pincl, 63);
        const unsigned incl = ptot - pincl + hcnt;
        const unsigned excl = incl - hcnt;
        unsigned cum = excl, vv = 0u, cbef = 0u, hv = 0u; bool fnd = false;
#pragma unroll
        for (int b = 3; b >= 0; --b) {
            if (!fnd && rrem <= cum + bb[b]) { fnd = true; vv = 4u * (unsigned)lane + (unsigned)b; cbef = cum; hv = bb[b]; }
            cum += bb[b];
        }
        const unsigned long long fm = __ballot(excl < rrem && rrem <= incl);
        const int srcl = fm ? (__ffsll((long long)fm) - 1) : 0;
        prefix |= (unsigned)__builtin_amdgcn_readlane((int)vv, srcl) << shift;
        rrem -= (unsigned)__builtin_amdgcn_readlane((int)cbef, srcl);
        m = (unsigned)__builtin_amdgcn_readlane((int)hv, srcl);
        bits_left = shift;
        if (!EXACT && (R - rrem) + m <= R + slack) break;
    }
    o.thr = prefix; o.cgt = R - rrem; return o;
}

__device__ __forceinline__ void phase_topk(const Args& a, unsigned char* lds, int wg, int nwg) {
    const bf16_t* P = (const bf16_t*)(a.ws + WS_P);
    bf16_t* YB = (bf16_t*)(a.ws + WS_YB);
    float* cs = (float*)lds;
    unsigned short* ci = (unsigned short*)(lds + TKO_CI);
    unsigned char* ikb = lds + TKO_IKB;
    unsigned* flag = (unsigned*)(lds + TKO_FLAG);
    int tid_ = threadIdx.x;
    const int wave = __builtin_amdgcn_readfirstlane((int)(threadIdx.x >> 6));
    unsigned* hist = (unsigned*)(lds + TKO_HIST) + wave * 128;
    unsigned* ictr = (unsigned*)(a.ws + WS_CTL) + 4048;
    for (;;) {
        asm volatile("" : "+v"(tid_));
        const int tid = tid_, lane = tid & 63, l31 = lane & 31, hi = lane >> 5;
        __syncthreads();
        if (tid == 0) flag[0] = atomicAdd(ictr, 1u);
        __syncthreads();
        const int it = (int)flag[0];
        if (it >= 512) break;
        const int idx = 511 - it;
        const int chunk = idx >> 1, hf = idx & 1, t0 = chunk * 64 + hf * 32, n = (chunk + 1) * 64;
        unsigned short* slots = (unsigned short*)ikb + (4 * wave) * 256;
        float* rw = cs + (4 * wave) * TK_CAP;
        if (n <= 256) {
            const unsigned b4 = 4u * lane;
#pragma unroll
            for (int qq = 0; qq < 4; ++qq) *(u32x2*)(slots + qq * 256 + 4 * lane) = (u32x2){b4 | ((b4 + 1u) << 16), (b4 + 2u) | ((b4 + 3u) << 16)};
        } else {
        __syncthreads();
        if (tid < 5) flag[tid] = 0u;
        const int tq0 = t0 + 4 * wave;
        bf16x8 afr[4];
        {
            const int q = 2 * (l31 >> 4) + ((l31 >> 2) & 1), hh = (l31 & 3) + 4 * ((l31 >> 3) & 1);
#pragma unroll
            for (int ks = 0; ks < 4; ++ks) afr[ks] = *(const bf16x8*)(P + (size_t)(tq0 + q) * NP + C_IQ + hh * 64 + ks * 16 + hi * 8);
        }
        float wq[2][8];
#pragma unroll
        for (int rd = 0; rd < 2; ++rd) {
            const u32x4 wr = *(const u32x4*)(P + (size_t)(tq0 + 2 * rd + hi) * NP + C_IW);
            const float sc = 0.35355339059f * 0.125f;
            wq[rd][0] = lo2f(wr.x) * sc; wq[rd][1] = hi2f(wr.x) * sc; wq[rd][2] = lo2f(wr.y) * sc; wq[rd][3] = hi2f(wr.y) * sc;
            wq[rd][4] = lo2f(wr.z) * sc; wq[rd][5] = hi2f(wr.z) * sc; wq[rd][6] = lo2f(wr.w) * sc; wq[rd][7] = hi2f(wr.w) * sc;
        }
        unsigned cnt[2] = {0u, 0u}, tauu[2] = {0u, 0u};
        float tauf[2] = {-INFINITY, -INFINITY};
        float taus[2] = {-INFINITY, -INFINITY};
        const int qbase[2] = {(4 * wave + hi) * TK_CAP, (4 * wave + 2 + hi) * TK_CAP};
        const int nblk = (n + 127) >> 7;
        int pass = (nblk >= 12) ? 0 : 2;
#pragma unroll 1
        for (;;) {
        const int kstep = (pass == 0) ? 4 : 1, kfirst = (pass == 0) ? 3 : 0;
        const unsigned rkeep = (pass == 0) ? (unsigned)TK_RS : 256u;
        if (pass != 1) { cnt[0] = 0u; cnt[1] = 0u; }
        tauf[0] = (pass == 1) ? taus[0] : -INFINITY; tauf[1] = (pass == 1) ? taus[1] : -INFINITY;
        if (tid < 4) flag[tid] = 0u;
        u32x4 st[2];
        {
#pragma unroll
            for (int i = 0; i < 2; ++i) {
                const int cid = tid + 512 * i, row = kfirst * 128 + (cid >> 3), kc = cid & 7;
                st[i] = (row < n) ? *(const u32x4*)(P + (size_t)row * NP + C_IK + kc * 8) : (u32x4){0u, 0u, 0u, 0u};
                *(u32x4*)(ikb + swz128(cid >> 3, kc)) = st[i];
            }
        }
        __syncthreads();
        int itc = 0;
        for (int kb = kfirst, knext; kb < nblk; kb = knext, ++itc) {
            knext = kb + kstep;
            if (pass == 1 && (knext & 3) == 3) ++knext;
            const int key0 = kb * 128, keyn = knext * 128;
            const bool more = knext < nblk;
            if (tid == 0) flag[(itc + 1) & 3] = 0u;
            if (more) {
#pragma unroll
                for (int i = 0; i < 2; ++i) {
                    const int cid = tid + 512 * i, row = cid >> 3, kc = cid & 7;
                    st[i] = (keyn + row < n) ? *(const u32x4*)(P + (size_t)(keyn + row) * NP + C_IK + kc * 8) : (u32x4){0u, 0u, 0u, 0u};
                }
            }
            const unsigned char* kbuf = ikb + (itc & 1) * 16384;
            const int ntile = (n - key0 >= 128) ? 4 : ((n - key0) >> 5);
            for (int kt = 0; kt < ntile; ++kt) {
                f32x16 z = zero16();
#pragma unroll
                for (int ks = 0; ks < 4; ++ks) {
                    const bf16x8 bfr = *(const bf16x8*)(kbuf + swz128(kt * 32 + l31, 2 * ks + hi));
                    z = __builtin_amdgcn_mfma_f32_32x32x16_bf16(afr[ks], bfr, z, 0, 0, 0);
                }
                const int key = key0 + kt * 32 + l31;
#pragma unroll
                for (int e = 0; e < 16; ++e) { const float zf = z[e]; const int zi = __float_as_int(zf); z[e] = __int_as_float(zi > 0 ? zi : 0); }
                f32x2 sa = (f32x2){0.f, 0.f}, sb = (f32x2){0.f, 0.f};
#pragma unroll
                for (int hp = 0; hp < 4; ++hp) {
                    sa = (f32x2){z[2 * hp], z[2 * hp + 1]} * (f32x2){wq[0][2 * hp], wq[0][2 * hp + 1]} + sa;
                    sb = (f32x2){z[8 + 2 * hp], z[8 + 2 * hp + 1]} * (f32x2){wq[1][2 * hp], wq[1][2 * hp + 1]} + sb;
                }
                const float sc2[2] = {sa.x + sa.y, sb.x + sb.y};
#pragma unroll
                for (int rd = 0; rd < 2; ++rd) {
                    const float s = sc2[rd];
                    const bool pred = s >= tauf[rd];
                    const unsigned long long mask = __ballot(pred);
                    const unsigned m32 = hi ? (unsigned)(mask >> 32) : (unsigned)mask;
                    const unsigned pos = cnt[rd] + __popc(m32 & ((1u << l31) - 1u));
                    const bool ok = pred && pos < (unsigned)TK_CAP;
                    const int slot = ok ? (qbase[rd] + (int)pos) : (32 * TK_CAP + lane);
                    cs[slot] = s; ci[slot] = (unsigned short)key;
                    cnt[rd] += __popc(m32);
                }
            }
            if (more) {
                unsigned char* nbuf = ikb + ((itc + 1) & 1) * 16384;
#pragma unroll
                for (int i = 0; i < 2; ++i) { const int cid = tid + 512 * i; *(u32x4*)(nbuf + swz128(cid >> 3, cid & 7)) = st[i]; }
            }
            if (cnt[0] > (unsigned)TK_CAP) cnt[0] = TK_CAP;
            if (cnt[1] > (unsigned)TK_CAP) cnt[1] = TK_CAP;
            if (cnt[0] > (unsigned)(TK_CAP - 128) || cnt[1] > (unsigned)(TK_CAP - 128)) flag[itc & 3] = 1u;
            __syncthreads();
            if (flag[itc & 3] != 0u && more) {
#pragma unroll 1
                for (int qq = 0; qq < 4; ++qq) {
                    const int rd = qq >> 1, hq = qq & 1;
                    const unsigned cq = __builtin_amdgcn_readlane(rd ? cnt[1] : cnt[0], 32 * hq);
                    if (cq <= rkeep + 32u) continue;
                    const int qi = 4 * wave + qq;
                    unsigned u[TK_NE]; bool valid[TK_NE]; float sv[TK_NE]; unsigned iv[TK_NE];
#pragma unroll
                    for (int i = 0; i < TK_NE; ++i) {
                        const unsigned j = TK_NE * lane + i;
                        valid[i] = j < cq;
                        sv[i] = cs[qi * TK_CAP + j];
                        iv[i] = (unsigned)ci[qi * TK_CAP + j];
                        u[i] = f2key(sv[i]);
                    }
                    const SelOut so = wave_select<false>(u, valid, cq, hist, lane, rkeep, 32u);
                    unsigned kc = 0u;
#pragma unroll
                    for (int i = 0; i < TK_NE; ++i) kc += (valid[i] && u[i] >= so.thr) ? 1u : 0u;
                    unsigned total;
                    unsigned pos = wave_excl_scan(kc, lane, total);
#pragma unroll
                    for (int i = 0; i < TK_NE; ++i) {
                        const bool keep = valid[i] && u[i] >= so.thr;
                        const int slot = keep ? (qi * TK_CAP + (int)pos) : (32 * TK_CAP + lane);
                        cs[slot] = sv[i]; ci[slot] = (unsigned short)iv[i];
                        pos += keep ? 1u : 0u;
                    }
                    wave_lds_sync();
                    if (hi == hq) {
                        const float tf = __uint_as_float((so.thr & 0x80000000u) ? (so.thr & 0x7fffffffu) : ~so.thr);
                        if (rd) { cnt[1] = total; tauu[1] = so.thr; tauf[1] = tf; } else { cnt[0] = total; tauu[0] = so.thr; tauf[0] = tf; }
                    }
                }
            }
        }
        if (pass == 0) {
#pragma unroll 1
            for (int qq = 0; qq < 4; ++qq) {
                const int rd = qq >> 1, hq = qq & 1;
                const unsigned cq = __builtin_amdgcn_readlane(rd ? cnt[1] : cnt[0], 32 * hq);
                const int qi = 4 * wave + qq;
                unsigned u[TK_NE]; bool valid[TK_NE];
#pragma unroll
                for (int i = 0; i < TK_NE; ++i) {
                    const unsigned j = TK_NE * lane + i;
                    valid[i] = j < cq;
                    u[i] = f2key(cs[qi * TK_CAP + j]);
                }
                const SelOut so = wave_select<true>(u, valid, cq, hist, lane, (unsigned)TK_RS, 0u);
                const unsigned thr = cq >= (unsigned)TK_RS ? so.thr : 0u;
                unsigned kc = 0u;
#pragma unroll
                for (int i = 0; i < TK_NE; ++i) kc += (valid[i] && u[i] >= thr) ? 1u : 0u;
                unsigned total;
                unsigned pos = wave_excl_scan(kc, lane, total);
                float sv[TK_NE]; unsigned iv[TK_NE];
#pragma unroll
                for (int i = 0; i < TK_NE; ++i) { const unsigned j = TK_NE * lane + i; sv[i] = cs[qi * TK_CAP + j]; iv[i] = (unsigned)ci[qi * TK_CAP + j]; }
                wave_lds_sync();
#pragma unroll
                for (int i = 0; i < TK_NE; ++i) {
                    const bool keep = valid[i] && u[i] >= thr;
                    const int slot = keep ? (qi * TK_CAP + (int)pos) : (32 * TK_CAP + lane);
                    cs[slot] = sv[i]; ci[slot] = (unsigned short)iv[i];
                    pos += keep ? 1u : 0u;
                }
                wave_lds_sync();
                if (hi == hq) {
                    const float tf = thr ? __uint_as_float((thr & 0x80000000u) ? (thr & 0x7fffffffu) : ~thr) : -INFINITY;
                    if (rd) { taus[1] = tf; cnt[1] = total; } else { taus[0] = tf; cnt[0] = total; }
                }
            }
            pass = 1;
            continue;
        }
        if (pass == 1) {
            if (cnt[0] < 256u || cnt[1] < 256u) flag[4] = 1u;
            __syncthreads();
            if (flag[4] == 0u) break;
            pass = 2;
            continue;
        }
        break;
        }
#pragma unroll 1
        for (int qq = 0; qq < 4; ++qq) {
            const int rd = qq >> 1, hq = qq & 1;
            const unsigned cq = __builtin_amdgcn_readlane(rd ? cnt[1] : cnt[0], 32 * hq);
            const int qi = 4 * wave + qq;
            unsigned u[TK_NE]; bool valid[TK_NE]; unsigned iv[TK_NE];
#pragma unroll
            for (int i = 0; i < TK_NE; ++i) {
                const unsigned j = TK_NE * lane + i;
                valid[i] = j < cq;
                u[i] = f2key(cs[qi * TK_CAP + j]);
                iv[i] = (unsigned)ci[qi * TK_CAP + j];
            }
            const SelOut so = wave_select<true>(u, valid, cq, hist, lane, 256u, 0u);
            const unsigned need = 256u - so.cgt;
            unsigned ge = 0u, gg = 0u;
#pragma unroll
            for (int i = 0; i < TK_NE; ++i) { ge += (valid[i] && u[i] == so.thr) ? 1u : 0u; gg += (valid[i] && u[i] > so.thr) ? 1u : 0u; }
            unsigned tot;
            const unsigned ebase = wave_excl_scan(ge, lane, tot);
            const unsigned etake = ebase >= need ? 0u : ((need - ebase) < ge ? (need - ebase) : ge);
            unsigned pos = wave_excl_scan(gg + etake, lane, tot);
            unsigned er = ebase;
            unsigned short* dst = slots + qq * 256;
#pragma unroll
            for (int i = 0; i < TK_NE; ++i) {
                const bool gt = valid[i] && u[i] > so.thr, eq = valid[i] && u[i] == so.thr;
                const bool take = gt || (eq && er < need);
                if (take && pos < 256u) dst[pos] = (unsigned short)iv[i];
                pos += take ? 1u : 0u; er += eq ? 1u : 0u;
            }
        }
        }
        wave_lds_sync();
        asm volatile("" : "+v"(tid_));
#pragma unroll 1
        for (int qq = 0; qq < 4; ++qq) attn_query(P, a.ws + WS_KV, YB, t0 + 4 * wave + qq, n < 256 ? n : 256, slots + qq * 256, rw, tid_ & 63);
    }
}

__device__ __forceinline__ int swzrow(int row, int chunk, int rowbytes) { return row * rowbytes + ((chunk ^ (row & 15)) << 4); }

__device__ __forceinline__ void phase_out(const Args& a, unsigned char* lds, int wg, int nwg) {
    const bf16_t* YA = (const bf16_t*)(a.ws + WS_YA);
    const bf16_t* YB = (const bf16_t*)(a.ws + WS_YB);
    const bf16_t* WfA = (const bf16_t*)(a.ws + WS_WTA);
    const bf16_t* WfB = (const bf16_t*)(a.ws + WS_WTB);
    const bf16_t* WfO = (const bf16_t*)(a.ws + WS_WTO);
    bf16_t* P = (bf16_t*)(a.ws + WS_P);
    const bf16_t* G = (const bf16_t*)a.out;
    const float* gate = (const float*)(a.ws + WS_MOD) + 2048;
    unsigned char* sYA = lds; unsigned char* sYB = lds + 65536; unsigned char* sM = lds;
    int tid_ = threadIdx.x; asm volatile("" : "+v"(tid_)); const int tid = tid_, lane = tid & 63, l31 = lane & 31, hi = lane >> 5;
    const int wave = __builtin_amdgcn_readfirstlane((int)(threadIdx.x >> 6));
    for (int tile = wg; tile < 256; tile += nwg) {
        const int m0 = tile * 64;
        __syncthreads();
#pragma unroll
        for (int i = 0; i < 8; ++i) {
            const int cid = tid + 512 * i, row = cid >> 6, ch = cid & 63;
            *(u32x4*)(sYA + swzrow(row, ch, 1024)) = *(const u32x4*)(YA + (size_t)(m0 + row) * 512 + ch * 8);
            *(u32x4*)(sYB + swzrow(row, ch, 1024)) = *(const u32x4*)(YB + (size_t)(m0 + row) * 512 + ch * 8);
        }
        __syncthreads();
#pragma unroll 1
        for (int half = 0; half < 2; ++half) {
            f32x16 ca[2][2], cb[2][2];
#pragma unroll
            for (int rt = 0; rt < 2; ++rt)
#pragma unroll
                for (int tt = 0; tt < 2; ++tt) { ca[rt][tt] = zero16(); cb[rt][tt] = zero16(); }
            const int R0 = 4 * wave + 2 * half;
            const bf16_t* pa = WfA + (size_t)R0 * 32 * 64 * 8;
            const bf16_t* pb = WfB + (size_t)R0 * 32 * 64 * 8;
            const unsigned lane16 = (unsigned)lane * 16u;
            bf16x8 sA[4], sB[4], sC[4], sD[4];
#define WAB_LOAD(dst, ksv) do { _Pragma("unroll") for (int rt = 0; rt < 2; ++rt) { \
                const bf16_t* p1_ = pa + ((size_t)rt * 32 + (ksv)) * 512; const bf16_t* p2_ = pb + ((size_t)rt * 32 + (ksv)) * 512; \
                asm volatile("global_load_dwordx4 %0, %1, %2" : "=v"(dst[rt]) : "v"(lane16), "s"(p1_) : "memory"); \
                asm volatile("global_load_dwordx4 %0, %1, %2" : "=v"(dst[2 + rt]) : "v"(lane16), "s"(p2_) : "memory"); } } while (0)
#define WAB_WAIT(dst) asm volatile("s_waitcnt vmcnt(12)" : "+v"(dst[0]), "+v"(dst[1]), "+v"(dst[2]), "+v"(dst[3]) :: "memory")
#define WAB_STEP(w_, ksv) do { bf16x8 by[2], bb[2]; \
                _Pragma("unroll") for (int tt = 0; tt < 2; ++tt) { by[tt] = *(const bf16x8*)(sYA + swzrow(32 * tt + l31, 2 * (ksv) + hi, 1024)); bb[tt] = *(const bf16x8*)(sYB + swzrow(32 * tt + l31, 2 * (ksv) + hi, 1024)); } \
                _Pragma("unroll") for (int rt = 0; rt < 2; ++rt) _Pragma("unroll") for (int tt = 0; tt < 2; ++tt) { \
                    ca[rt][tt] = __builtin_amdgcn_mfma_f32_32x32x16_bf16(w_[rt], by[tt], ca[rt][tt], 0, 0, 0); \
                    cb[rt][tt] = __builtin_amdgcn_mfma_f32_32x32x16_bf16(w_[2 + rt], bb[tt], cb[rt][tt], 0, 0, 0); } } while (0)
            asm volatile("s_waitcnt vmcnt(0)" ::: "memory");
            WAB_LOAD(sA, 0); WAB_LOAD(sB, 1); WAB_LOAD(sC, 2);
#pragma unroll 1
            for (int ks = 0; ks < 32; ks += 4) {
                WAB_LOAD(sD, ks + 3);                        WAB_WAIT(sA); WAB_STEP(sA, ks);
                WAB_LOAD(sA, (ks + 4 < 32) ? ks + 4 : 31);   WAB_WAIT(sB); WAB_STEP(sB, ks + 1);
                WAB_LOAD(sB, (ks + 5 < 32) ? ks + 5 : 31);   WAB_WAIT(sC); WAB_STEP(sC, ks + 2);
                WAB_LOAD(sC, (ks + 6 < 32) ? ks + 6 : 31);   WAB_WAIT(sD); WAB_STEP(sD, ks + 3);
            }
            asm volatile("s_waitcnt vmcnt(0)" : "+v"(sA[0]), "+v"(sA[1]), "+v"(sA[2]), "+v"(sA[3]), "+v"(sB[0]), "+v"(sB[1]), "+v"(sB[2]), "+v"(sB[3]),
                                                "+v"(sC[0]), "+v"(sC[1]), "+v"(sC[2]), "+v"(sC[3]) :: "memory");
#undef WAB_LOAD
#undef WAB_WAIT
#undef WAB_STEP
#pragma unroll
            for (int rt = 0; rt < 2; ++rt)
#pragma unroll
                for (int tt = 0; tt < 2; ++tt) {
                    const int n = 32 * (R0 + rt) + 16 * hi, m = m0 + 32 * tt + l31;
                    const u32x4 ga0 = *(const u32x4*)(G + (size_t)m * 2048 + n), ga1 = *(const u32x4*)(G + (size_t)m * 2048 + n + 8);
                    const u32x4 gb0 = *(const u32x4*)(G + (size_t)m * 2048 + 1024 + n), gb1 = *(const u32x4*)(G + (size_t)m * 2048 + 1024 + n + 8);
                    const unsigned gaw[8] = {ga0.x, ga0.y, ga0.z, ga0.w, ga1.x, ga1.y, ga1.z, ga1.w};
                    const unsigned gbw[8] = {gb0.x, gb0.y, gb0.z, gb0.w, gb1.x, gb1.y, gb1.z, gb1.w};
                    unsigned mw[8];
#pragma unroll
                    for (int p = 0; p < 8; ++p) {
                        const float v0 = lo2f(gaw[p]) * ca[rt][tt][2 * p] + lo2f(gbw[p]) * cb[rt][tt][2 * p];
                        const float v1 = hi2f(gaw[p]) * ca[rt][tt][2 * p + 1] + hi2f(gbw[p]) * cb[rt][tt][2 * p + 1];
                        mw[p] = pack2(v0, v1);
                    }
                    bf16_t* dst = P + (size_t)m * NP + C_Q + n;
                    *(u32x4*)dst = (u32x4){mw[0], mw[1], mw[2], mw[3]};
                    *(u32x4*)(dst + 8) = (u32x4){mw[4], mw[5], mw[6], mw[7]};
                }
        }
        asm volatile("s_waitcnt vmcnt(0)" ::: "memory");
        __syncthreads();
        int tidb_ = threadIdx.x; asm volatile("" : "+v"(tidb_)); const int tid = tidb_, lane = tid & 63, l31 = lane & 31, hi = lane >> 5;
#pragma unroll
        for (int i = 0; i < 16; ++i) {
            const int cid = tid + 512 * i, row = cid >> 7, ch = cid & 127;
            *(u32x4*)(sM + swzrow(row, ch, 2048)) = *(const u32x4*)(P + (size_t)(m0 + row) * NP + C_Q + ch * 8);
        }
        __syncthreads();
        {
            f32x16 acc[4][2];
#pragma unroll
            for (int rt = 0; rt < 4; ++rt)
#pragma unroll
                for (int tt = 0; tt < 2; ++tt) acc[rt][tt] = zero16();
            const bf16_t* po = WfO + (size_t)(4 * wave) * 64 * 64 * 8;
            const unsigned lane16 = (unsigned)lane * 16u;
            bf16x8 wA[4], wB[4], wC[4], wD[4];
#define WO_LOAD(dst, ksv) do { _Pragma("unroll") for (int rt = 0; rt < 4; ++rt) { const bf16_t* p_ = po + ((size_t)rt * 64 + (ksv)) * 512; \
                asm volatile("global_load_dwordx4 %0, %1, %2" : "=v"(dst[rt]) : "v"(lane16), "s"(p_) : "memory"); } } while (0)
#define WO_WAIT(dst) asm volatile("s_waitcnt vmcnt(12)" : "+v"(dst[0]), "+v"(dst[1]), "+v"(dst[2]), "+v"(dst[3]) :: "memory")
#define WO_STEP(w_, ksv) do { bf16x8 bm[2]; _Pragma("unroll") for (int tt = 0; tt < 2; ++tt) bm[tt] = *(const bf16x8*)(sM + swzrow(32 * tt + l31, 2 * (ksv) + hi, 2048)); \
                _Pragma("unroll") for (int rt = 0; rt < 4; ++rt) _Pragma("unroll") for (int tt = 0; tt < 2; ++tt) \
                    acc[rt][tt] = __builtin_amdgcn_mfma_f32_32x32x16_bf16(w_[rt], bm[tt], acc[rt][tt], 0, 0, 0); } while (0)
            asm volatile("s_waitcnt vmcnt(0)" ::: "memory");
            WO_LOAD(wA, 0); WO_LOAD(wB, 1); WO_LOAD(wC, 2);
#pragma unroll 1
            for (int ks = 0; ks < 64; ks += 4) {
                WO_LOAD(wD, ks + 3);                        WO_WAIT(wA); WO_STEP(wA, ks);
                WO_LOAD(wA, (ks + 4 < 64) ? ks + 4 : 63);   WO_WAIT(wB); WO_STEP(wB, ks + 1);
                WO_LOAD(wB, (ks + 5 < 64) ? ks + 5 : 63);   WO_WAIT(wC); WO_STEP(wC, ks + 2);
                WO_LOAD(wC, (ks + 6 < 64) ? ks + 6 : 63);   WO_WAIT(wD); WO_STEP(wD, ks + 3);
            }
            asm volatile("s_waitcnt vmcnt(0)" : "+v"(wA[0]), "+v"(wA[1]), "+v"(wA[2]), "+v"(wA[3]), "+v"(wB[0]), "+v"(wB[1]), "+v"(wB[2]), "+v"(wB[3]),
                                                "+v"(wC[0]), "+v"(wC[1]), "+v"(wC[2]), "+v"(wC[3]) :: "memory");
#undef WO_LOAD
#undef WO_WAIT
#undef WO_STEP
#pragma unroll
            for (int rt = 0; rt < 4; ++rt)
#pragma unroll
                for (int tt = 0; tt < 2; ++tt) {
                    const int n = 128 * wave + 32 * rt + 16 * hi, m = m0 + 32 * tt + l31;
#pragma unroll
                    for (int r4 = 0; r4 < 4; ++r4) {
                        const f32x4 xv = *(const f32x4*)(a.x + (size_t)m * 1024 + n + 4 * r4);
                        const f32x4 gv = *(const f32x4*)(gate + n + 4 * r4);
                        f32x4 o;
                        o.x = xv.x + gv.x * acc[rt][tt][4 * r4 + 0]; o.y = xv.y + gv.y * acc[rt][tt][4 * r4 + 1];
                        o.z = xv.z + gv.z * acc[rt][tt][4 * r4 + 2]; o.w = xv.w + gv.w * acc[rt][tt][4 * r4 + 3];
                        *(f32x4*)(a.out + (size_t)m * 1024 + n + 4 * r4) = o;
                    }
                }
        }
    }
}

#define XB_TMO      128
#define XB_XCNT(j)  (256  + 64 * (j))
#define XB_XSUB(j)  (1280 + 64 * (j))
#define XB_XGEN(j)  (2304 + 64 * (j))
#define XB_TOP      3328
#define XB_TOPGEN   3392
#define XCD_BAR_WORDS 3456
#define XB_SPIN_CAP (1u << 22)
__device__ __forceinline__ unsigned xb_ld(unsigned* p)              { return __hip_atomic_load(p, __ATOMIC_RELAXED, __HIP_MEMORY_SCOPE_AGENT); }
__device__ __forceinline__ unsigned xb_add(unsigned* p, unsigned v) { return __hip_atomic_fetch_add(p, v, __ATOMIC_RELAXED, __HIP_MEMORY_SCOPE_AGENT); }
__device__ __forceinline__ unsigned xb_xcc_id() { return (unsigned)__builtin_amdgcn_s_getreg((3 << 11) | 20) & 0xFu; }
#define XB_SPIN(cond, bar) do { unsigned _sp = 0; while (cond) { __builtin_amdgcn_s_sleep(1); \
    if ((++_sp & 255u) == 0u) { if (xb_ld(&(bar)[XB_TMO])) break; if (_sp > XB_SPIN_CAP) { atomicAdd(&(bar)[XB_TMO], 1u); break; } } } } while (0)
__device__ __forceinline__ void xcd_barrier_post(unsigned* bar) {
    if (threadIdx.x == 0) (void)xb_add(&bar[XB_XCNT(xb_xcc_id())], 1u);
}
__device__ __forceinline__ void xcd_barrier_complete(unsigned* bar, unsigned x, unsigned& nloc, unsigned& nx) {
    const unsigned G = gridDim.x * gridDim.y * gridDim.z;
    unsigned sum, cnt, mine, sp = 0u;
    for (;;) {
        sum = 0u; cnt = 0u; mine = 0u;
#pragma unroll
        for (unsigned j = 0; j < 16; ++j) { const unsigned c = xb_ld(&bar[XB_XCNT(j)]); sum += c; cnt += (c > 0u) ? 1u : 0u; mine = (j == x) ? c : mine; }
        if (sum == G) break;
        __builtin_amdgcn_s_sleep(1);
        if ((++sp & 255u) == 0u) { if (xb_ld(&bar[XB_TMO])) break; if (sp > XB_SPIN_CAP) { atomicAdd(&bar[XB_TMO], 1u); break; } }
    }
    nloc = mine > 0u ? mine : 1u; nx = cnt > 0u ? cnt : 1u;
}
__device__ __forceinline__ void xcd_barrier(unsigned* bar) {
    asm volatile("s_waitcnt vmcnt(0)" ::: "memory");
    __syncthreads();
    if (threadIdx.x == 0) {
        __builtin_amdgcn_s_waitcnt(0);
        struct { unsigned x; } b; b.x = xb_xcc_id();
        unsigned* slot = bar + XCD_BAR_WORDS + 2 * blockIdx.x;
        unsigned nloc = xb_ld(slot), nx = xb_ld(slot + 1);
        if (nloc == 0u) { xcd_barrier_complete(bar, b.x, nloc, nx); __hip_atomic_store(slot, nloc, __ATOMIC_RELAXED, __HIP_MEMORY_SCOPE_AGENT); __hip_atomic_store(slot + 1, nx, __ATOMIC_RELAXED, __HIP_MEMORY_SCOPE_AGENT); }
        const unsigned old = xb_add(&bar[XB_XSUB(b.x)], 1u);
        const unsigned gen = old / nloc;
        if (old + 1u == (gen + 1u) * nloc) {
            __builtin_amdgcn_fence(__ATOMIC_RELEASE, "agent");
            asm volatile("s_waitcnt vmcnt(0)" ::: "memory");
            const unsigned og = xb_add(&bar[XB_TOP], 1u);
            const unsigned tg = og / nx;
            if (og + 1u == (tg + 1u) * nx) xb_add(&bar[XB_TOPGEN], 1u);
            else XB_SPIN(xb_ld(&bar[XB_TOPGEN]) == tg, bar);
            __builtin_amdgcn_fence(__ATOMIC_ACQUIRE, "agent");
            xb_add(&bar[XB_XGEN(b.x)], 1u);
            asm volatile("s_waitcnt vmcnt(0)" ::: "memory");
        } else {
            XB_SPIN(xb_ld(&bar[XB_XGEN(b.x)]) == gen, bar);
            __builtin_amdgcn_fence(__ATOMIC_ACQUIRE, "agent");
            asm volatile("s_waitcnt vmcnt(0)" ::: "memory");
        }
    }
    __syncthreads();
}

#define DECL_LDS extern __shared__ __attribute__((aligned(16))) unsigned char lds[]
__global__ void __launch_bounds__(NTHR) mk_fwd(Args a) {
    DECL_LDS;
    const int wg = blockIdx.x, nwg = gridDim.x;
    unsigned* bar = (unsigned*)(a.ws + WS_CTL);
    xcd_barrier_post(bar);
    convert_weightT<1>(a.w_in, 1024, 6856, (bf16_t*)(a.ws + WS_WTIN), NW, (float*)lds, wg, nwg);
    convert_weightF(a.w_a_out, 512, 1024, (bf16_t*)(a.ws + WS_WTA), 1024, (float*)lds, wg, nwg);
    convert_weightF(a.w_b_out, 512, 1024, (bf16_t*)(a.ws + WS_WTB), 1024, (float*)lds, wg, nwg);
    convert_weightF(a.w_o, 1024, 1024, (bf16_t*)(a.ws + WS_WTO), 1024, (float*)lds, wg, nwg);
    convert_weightT<2>(a.w_up, 64, 512, (bf16_t*)(a.ws + WS_WUPT), 512, (float*)lds, wg, nwg);
    convert_weightT<2>(a.a_up, 64, 512, (bf16_t*)(a.ws + WS_AUPT), 512, (float*)lds, wg, nwg);
    phase_ada(a, (float*)lds, wg, nwg);
    xcd_barrier(bar);
    phase_h(a, wg, nwg);
    xcd_barrier(bar);
    phase_gemm1(a, lds, wg, nwg);
    xcd_barrier(bar);
    phase_rwkv_chunk<1>(a, lds, wg, nwg);
    xcd_barrier(bar);
    phase_rwkv_scan(a, wg);
    phase_topk(a, lds, wg, nwg);
    xcd_barrier(bar);
    phase_rwkv_chunk<2>(a, lds, wg, nwg);
    asm volatile("s_waitcnt vmcnt(0)" ::: "memory");
    __syncthreads();
    phase_out(a, lds, wg, nwg);
}

extern "C" void kernel_launch(void* const* d_in, const int* in_sizes, int n_in, void* d_out, int out_size, void* d_ws, size_t ws_size, hipStream_t stream) {
    static int grid = 0;
    if (grid == 0) {
        if (n_in != 21 || ws_size < WS_END || out_size != M_TOK * DM) { fprintf(stderr, "kernel_launch: unexpected shapes n_in %d ws %zu out %d\n", n_in, ws_size, out_size); grid = -1; return; }
        int dev = 0, cus = 0;
        if (hipGetDevice(&dev) != hipSuccess || hipDeviceGetAttribute(&cus, hipDeviceAttributeMultiprocessorCount, dev) != hipSuccess) { grid = -1; return; }
        if (hipFuncSetAttribute((const void*)mk_fwd, hipFuncAttributeMaxDynamicSharedMemorySize, LDS_BYTES) != hipSuccess) { fprintf(stderr, "kernel_launch: hipFuncSetAttribute failed\n"); grid = -1; return; }
        int per_cu = 0;
        if (hipOccupancyMaxActiveBlocksPerMultiprocessor(&per_cu, (const void*)mk_fwd, NTHR, LDS_BYTES) != hipSuccess || per_cu < 1) { fprintf(stderr, "kernel_launch: occupancy query says %d workgroups per CU\n", per_cu); (void)hipGetLastError(); }
        grid = cus;
    }
    if (grid < 0) return;
    (void)hipMemsetAsync((char*)d_ws + WS_CTL, 0, 16384, stream);
    Args a{};
    const float** pp = (const float**)&a;
    for (int i = 0; i < 21; ++i) pp[i] = (const float*)d_in[i];
    a.out = (float*)d_out; a.ws = (unsigned char*)d_ws;
    hipLaunchKernelGGL(mk_fwd, dim3(grid), dim3(NTHR), LDS_BYTES, stream, a);
}
```

```cpp
#include <hip/hip_runtime.h>
#include <stdint.h>
#include <stdio.h>

typedef unsigned short bf16_t;
typedef short bf16x8 __attribute__((ext_vector_type(8)));
typedef float f32x16 __attribute__((ext_vector_type(16)));
typedef float f32x4 __attribute__((ext_vector_type(4)));
typedef float f32x2 __attribute__((ext_vector_type(2)));
typedef unsigned u32x4 __attribute__((ext_vector_type(4)));
typedef unsigned u32x2 __attribute__((ext_vector_type(2)));

#ifndef N_LAUNCHES
#define N_LAUNCHES 7
#endif

constexpr int M_TOK = 16384, DM = 1024;
constexpr int NW = 6912;
constexpr int NP = 4864;
constexpr int NTHR = 512;
constexpr int LDS_BYTES = 160 * 1024;
constexpr int C_R = 0, C_K = 512, C_V = 1024, C_WD = 1536, C_AD = 1600, C_G = 1664;
constexpr int C_Q = 2176, C_AK = 2688, C_AV = 3200, C_GB = 3712, C_IQ = 4224, C_IK = 4736, C_IW = 4800;
constexpr size_t WS_CTL = 0, WS_MOD = 16384, WS_WTIN = 32768;
constexpr size_t WS_WTA = WS_WTIN + (size_t)NW * 1024 * 2;
constexpr size_t WS_WTB = WS_WTA + 1024 * 512 * 2;
constexpr size_t WS_WTO = WS_WTB + 1024 * 512 * 2;
constexpr size_t WS_H = WS_WTO + 1024 * 1024 * 2;
constexpr size_t WS_P = WS_H + (size_t)M_TOK * 1024 * 2;
constexpr size_t WS_SEL = WS_P + (size_t)M_TOK * NP * 2;
constexpr size_t WS_YA = WS_SEL + (size_t)M_TOK * 256 * 2;
constexpr size_t WS_KV = WS_YA;
constexpr size_t WS_YB = WS_YA + (size_t)M_TOK * 512 * 2;
constexpr size_t WS_WUPT = WS_YB + (size_t)M_TOK * 512 * 2;
constexpr size_t WS_AUPT = WS_WUPT + 512 * 64 * 2;
constexpr size_t WS_GL = WS_AUPT + 512 * 64 * 2;
constexpr size_t WS_END = WS_GL + 2048 * 64 * 4;
constexpr size_t WS_RM = WS_H;
constexpr size_t WS_RC = WS_H + (size_t)2048 * 8192;
static_assert(WS_END <= 268435456ull, "workspace");

struct Args {
    const float *x, *c, *norm_w, *w_ada, *b_ada, *w_in, *mu, *w0, *w_up, *a0, *a_up, *k_k, *k_a, *r_k, *gn_w, *gn_b, *q_gain, *k_gain, *w_a_out, *w_b_out, *w_o;
    float* out; unsigned char* ws; int ph_lo, ph_hi;
};

__device__ __forceinline__ float bf2f(unsigned short b) { return __uint_as_float(((unsigned)b) << 16); }
typedef __bf16 bf16x2_t __attribute__((ext_vector_type(2)));
__device__ __forceinline__ unsigned short f2bf(float f) { return __builtin_bit_cast(unsigned short, (__bf16)f); }
__device__ __forceinline__ unsigned pack2(float lo, float hi) { bf16x2_t v; v.x = (__bf16)lo; v.y = (__bf16)hi; return __builtin_bit_cast(unsigned, v); }
__device__ __forceinline__ float lo2f(unsigned w) { return __uint_as_float(w << 16); }
__device__ __forceinline__ float hi2f(unsigned w) { return __uint_as_float(w & 0xffff0000u); }
__device__ __forceinline__ float sigmoidf_(float x) { return 1.f / (1.f + __expf(-x)); }
__device__ __forceinline__ float tanhf_(float x) { return 1.f - 2.f * __builtin_amdgcn_rcpf(1.f + __expf(2.f * x)); }
__device__ __forceinline__ float wave_sum(float v) {
#pragma unroll
    for (int o = 32; o > 0; o >>= 1) v += __shfl_xor(v, o);
    return v;
}
template <int CTRL, int RM, int BM>
__device__ __forceinline__ unsigned dppu(unsigned v) { return (unsigned)__builtin_amdgcn_update_dpp(0, (int)v, CTRL, RM, BM, false); }
template <int CTRL>
__device__ __forceinline__ float dppf(float v) { return __int_as_float(__builtin_amdgcn_update_dpp(0, __float_as_int(v), CTRL, 0xf, 0xf, false)); }
__device__ __forceinline__ float sum4_dpp(float v) { v += dppf<0xB1>(v); v += dppf<0x4E>(v); return v; }
__device__ __forceinline__ float sum8_dpp(float v) { v += dppf<0xB1>(v); v += dppf<0x4E>(v); v += dppf<0x141>(v); return v; }
__device__ __forceinline__ unsigned wave_incl_scan_dpp(unsigned v) {
    unsigned s = v + dppu<0x111, 0xf, 0xf>(v);
    s += dppu<0x112, 0xf, 0xf>(v);
    s += dppu<0x113, 0xf, 0xf>(v);
    s += dppu<0x114, 0xf, 0xe>(s);
    s += dppu<0x118, 0xf, 0xc>(s);
    s += dppu<0x142, 0xa, 0xf>(s);
    s += dppu<0x143, 0xc, 0xf>(s);
    return s;
}
__device__ __forceinline__ unsigned wave_or_dpp(unsigned v) {
    v |= dppu<0xB1, 0xf, 0xf>(v); v |= dppu<0x4E, 0xf, 0xf>(v);
    v |= dppu<0x114, 0xf, 0xf>(v); v |= dppu<0x118, 0xf, 0xf>(v);
    v |= dppu<0x142, 0xa, 0xf>(v); v |= dppu<0x143, 0xc, 0xf>(v);
    return (unsigned)__builtin_amdgcn_readlane((int)v, 63);
}
__device__ __forceinline__ unsigned f2key(float f) { unsigned u = __float_as_uint(f); return (u & 0x80000000u) ? ~u : (u | 0x80000000u); }
__device__ __forceinline__ void wave_lds_sync() { __builtin_amdgcn_wave_barrier(); asm volatile("s_waitcnt lgkmcnt(0)" ::: "memory"); __builtin_amdgcn_wave_barrier(); }

template <int MODE>
__device__ __forceinline__ void convert_weightT(const float* __restrict__ src, int K, int Nsrc, bf16_t* __restrict__ dst, int Ndst, float* tile, int wg, int nwg) {
    const int ntn = Ndst / 64, ntk = K / 64;
    int tid_ = threadIdx.x; asm volatile("" : "+v"(tid_)); const int tid = tid_;
    for (int it = wg; it < ntn * ntk; it += nwg) {
        const int tn = it % ntn, tk = it / ntn;
        const int n0 = tn * 64, k0 = tk * 64;
        __syncthreads();
        {
            const int nn = tid & 63, kk0 = tid >> 6;
            const int np = n0 + nn, g = np >> 6, rho = np & 63;
            const int c = (MODE == 2) ? np : ((g << 6) + 16 * ((rho >> 2) & 3) + 4 * (rho >> 4) + (rho & 3));
            int sc = c;
            if (MODE == 1) sc = (c < 4808) ? c : ((c < 4864) ? -1 : c - 56);
#pragma unroll
            for (int i8 = 0; i8 < 8; ++i8) {
                const int kk = kk0 + 8 * i8;
                float v = (sc >= 0) ? src[(size_t)(k0 + kk) * Nsrc + sc] : 0.f;
                tile[kk * 65 + nn] = v;
            }
        }
        __syncthreads();
        {
            const int wn = tid >> 3, kq = tid & 7;
            u32x4 o;
            o.x = pack2(tile[(8 * kq + 0) * 65 + wn], tile[(8 * kq + 1) * 65 + wn]);
            o.y = pack2(tile[(8 * kq + 2) * 65 + wn], tile[(8 * kq + 3) * 65 + wn]);
            o.z = pack2(tile[(8 * kq + 4) * 65 + wn], tile[(8 * kq + 5) * 65 + wn]);
            o.w = pack2(tile[(8 * kq + 6) * 65 + wn], tile[(8 * kq + 7) * 65 + wn]);
            *(u32x4*)(dst + (size_t)(n0 + wn) * K + k0 + 8 * kq) = o;
        }
    }
}

__device__ __forceinline__ void convert_weightF(const float* __restrict__ src, int K, int Nsrc, bf16_t* __restrict__ dst, int Ndst, float* tile, int wg, int nwg) {
    const int ntn = Ndst / 64, ntk = K / 64, KS = K / 32;
    int tid_ = threadIdx.x; asm volatile("" : "+v"(tid_)); const int tid = tid_;
    for (int it = wg; it < ntn * ntk; it += nwg) {
        const int tn = it % ntn, tk = it / ntn;
        const int n0 = tn * 64, k0 = tk * 64;
        __syncthreads();
        {
            const int nn = tid & 63, kk0 = tid >> 6;
            const int rho = nn;
            const int c = n0 + 16 * ((rho >> 2) & 3) + 4 * (rho >> 4) + (rho & 3);
#pragma unroll
            for (int i8 = 0; i8 < 8; ++i8) { const int kk = kk0 + 8 * i8; tile[kk * 65 + nn] = src[(size_t)(k0 + kk) * Nsrc + c]; }
        }
        __syncthreads();
        {
            const int ln = tid & 63, blk = tid >> 6, Rl = blk >> 1, ksl = blk & 1;
            const int nn = 16 * Rl + (ln & 15), kb = 32 * ksl + 8 * (ln >> 4);
            u32x4 o;
            o.x = pack2(tile[(kb + 0) * 65 + nn], tile[(kb + 1) * 65 + nn]); o.y = pack2(tile[(kb + 2) * 65 + nn], tile[(kb + 3) * 65 + nn]);
            o.z = pack2(tile[(kb + 4) * 65 + nn], tile[(kb + 5) * 65 + nn]); o.w = pack2(tile[(kb + 6) * 65 + nn], tile[(kb + 7) * 65 + nn]);
            *(u32x4*)(dst + ((size_t)((n0 / 16 + Rl) * KS + k0 / 32 + ksl) * 64 + ln) * 8) = o;
        }
    }
}

__device__ __forceinline__ void phase_ada(const Args& a, float* lds, int wg, int nwg) {
    int tid_ = threadIdx.x; asm volatile("" : "+v"(tid_)); const int tid = tid_, lane = tid & 63, wave = tid >> 6;
    float* mod = (float*)(a.ws + WS_MOD);
    __syncthreads();
    for (int i = tid; i < 1024; i += NTHR) { float v = a.c[i]; lds[i] = v / (1.f + expf(-v)); }
    __syncthreads();
    for (int cg = wg; cg < 256; cg += nwg) {
        const int j0 = cg * 12;
        float acc[12];
#pragma unroll
        for (int j = 0; j < 12; ++j) acc[j] = 0.f;
        for (int k = tid; k < 1024; k += NTHR) {
            const float s = lds[k];
            const float* row = a.w_ada + (size_t)k * 3072 + j0;
            const f32x4 v0 = *(const f32x4*)row, v1 = *(const f32x4*)(row + 4), v2 = *(const f32x4*)(row + 8);
            acc[0] += s * v0.x; acc[1] += s * v0.y; acc[2] += s * v0.z; acc[3] += s * v0.w;
            acc[4] += s * v1.x; acc[5] += s * v1.y; acc[6] += s * v1.z; acc[7] += s * v1.w;
            acc[8] += s * v2.x; acc[9] += s * v2.y; acc[10] += s * v2.z; acc[11] += s * v2.w;
        }
#pragma unroll
        for (int j = 0; j < 12; ++j) acc[j] = wave_sum(acc[j]);
        if (lane == 0) {
#pragma unroll
            for (int j = 0; j < 12; ++j) lds[1024 + wave * 12 + j] = acc[j];
        }
        __syncthreads();
        if (tid < 12) {
            float s = a.b_ada[j0 + tid];
#pragma unroll
            for (int w = 0; w < 8; ++w) s += lds[1024 + w * 12 + tid];
            mod[j0 + tid] = s;
        }
        __syncthreads();
    }
}

__device__ __forceinline__ void phase_h(const Args& a, int wg, int nwg) {
    int tid_ = threadIdx.x; asm volatile("" : "+v"(tid_)); const int tid = tid_, lane = tid & 63, wave = tid >> 6;
    const float* mod = (const float*)(a.ws + WS_MOD);
    bf16_t* H = (bf16_t*)(a.ws + WS_H);
    f32x4 nw[4], sc1[4], sh[4];
#pragma unroll
    for (int i = 0; i < 4; ++i) {
        const int col = 256 * i + 4 * lane;
        nw[i] = *(const f32x4*)(a.norm_w + col);
        sh[i] = *(const f32x4*)(mod + col);
        sc1[i] = *(const f32x4*)(mod + 1024 + col);
        sc1[i] = sc1[i] + 1.0f;
    }
    for (int row = wg * 8 + wave; row < M_TOK; row += nwg * 8) {
        f32x4 v[4]; float ss = 0.f;
#pragma unroll
        for (int i = 0; i < 4; ++i) {
            v[i] = *(const f32x4*)(a.x + (size_t)row * 1024 + 256 * i + 4 * lane);
            ss += v[i].x * v[i].x + v[i].y * v[i].y + v[i].z * v[i].z + v[i].w * v[i].w;
        }
        ss = wave_sum(ss);
        const float rstd = rsqrtf(ss * (1.f / 1024.f) + 1e-6f);
#pragma unroll
        for (int i = 0; i < 4; ++i) {
            const f32x4 y = v[i] * rstd * nw[i];
            const f32x4 hv = y * sc1[i] + sh[i];
            u32x2 o; o.x = pack2(hv.x, hv.y); o.y = pack2(hv.z, hv.w);
            *(u32x2*)(H + (size_t)row * 1024 + 256 * i + 4 * lane) = o;
        }
    }
}

__device__ __forceinline__ f32x16 zero16() { f32x16 z;
#pragma unroll
    for (int r = 0; r < 16; ++r) z[r] = 0.f;
    return z; }
__device__ __forceinline__ int swz128(int row, int kc) { return row * 128 + ((kc ^ ((row >> 1) & 7)) << 4); }

__device__ __forceinline__ void phase_gemm1(const Args& a, unsigned char* lds, int wg, int nwg) {
    const bf16_t* Wt = (const bf16_t*)(a.ws + WS_WTIN);
    const bf16_t* H = (const bf16_t*)(a.ws + WS_H);
    bf16_t* P = (bf16_t*)(a.ws + WS_P);
    bf16_t* G = (bf16_t*)a.out;
    int tid_ = threadIdx.x; asm volatile("" : "+v"(tid_)); const int tid = tid_, lane = tid & 63;
    const int wave = __builtin_amdgcn_readfirstlane((int)(threadIdx.x >> 6));
    const int wn = wave & 3, wm = wave >> 2, l31 = lane & 31, hi = lane >> 5;
    for (int rnd = 0; rnd < 7 * ((256 + nwg - 1) / nwg); ++rnd) {
        int nt, mt;
        if (nwg == 256) {
            const int super = rnd * 8 + (wg & 7), slot = wg >> 3;
            mt = (super / 7) * 8 + (slot & 7); nt = (super % 7) * 4 + (slot >> 3);
        } else {
            const int tile = wg + rnd * nwg; nt = tile % 28; mt = tile / 28;
        }
        if (nt >= 27 || mt >= 64) continue;
        const int n0 = nt * 256, m0 = mt * 256;
        f32x4 acc[4][8];
#pragma unroll
        for (int i = 0; i < 4; ++i)
#pragma unroll
            for (int j = 0; j < 8; ++j) acc[i][j] = (f32x4){0.f, 0.f, 0.f, 0.f};
        const int l15 = lane & 15, q4 = lane >> 4;
        const int xs_ = (l15 >> 1) & 7;
        const int cA0 = wn * 8192 + l15 * 128 + ((q4 ^ xs_) << 4), cA1 = wn * 8192 + l15 * 128 + (((4 + q4) ^ xs_) << 4);
        const int cB0 = 32768 + wm * 16384 + l15 * 128 + ((q4 ^ xs_) << 4), cB1 = 32768 + wm * 16384 + l15 * 128 + (((4 + q4) ^ xs_) << 4);
        const int prow = lane >> 3, pch = lane & 7;
        unsigned voff[4];
#pragma unroll
        for (int i = 0; i < 4; ++i) { const int row = 8 * (wave + 8 * i) + prow; voff[i] = (unsigned)((row * 1024 + ((pch ^ ((row >> 1) & 7)) << 3)) * 2); }
        const unsigned char* wbase = (const unsigned char*)(Wt + (size_t)n0 * 1024);
        const unsigned char* hbase = (const unsigned char*)(H + (size_t)m0 * 1024);
        auto stage = [&](int buf, int kt) {
#pragma unroll
            for (int i = 0; i < 4; ++i) {
                const int p = wave + 8 * i;
                __builtin_amdgcn_global_load_lds((const unsigned*)(wbase + kt * 128 + voff[i]), (__attribute__((address_space(3))) unsigned*)(lds + buf * 65536 + p * 1024), 16, 0, 0);
                __builtin_amdgcn_global_load_lds((const unsigned*)(hbase + kt * 128 + voff[i]), (__attribute__((address_space(3))) unsigned*)(lds + buf * 65536 + 32768 + p * 1024), 16, 0, 0);
            }
        };
        __syncthreads();
        stage(0, 0);
        __syncthreads();
        for (int kt = 0; kt < 16; ++kt) {
            if (kt + 1 < 16) stage((kt + 1) & 1, kt + 1);
            const unsigned char* base = lds + (kt & 1) * 65536;
#define G1_RA(dst, ksv) do { _Pragma("unroll") for (int i = 0; i < 4; ++i) dst[i] = *(const bf16x8*)(base + ((ksv) ? cA1 : cA0) + i * 2048); } while (0)
#define G1_RB(dst, ksv, jh) do { _Pragma("unroll") for (int j = 0; j < 4; ++j) dst[j] = *(const bf16x8*)(base + ((ksv) ? cB1 : cB0) + (4 * (jh) + j) * 2048); } while (0)
#define G1_MM(av, bv, jh) do { _Pragma("unroll") for (int i = 0; i < 4; ++i) _Pragma("unroll") for (int j = 0; j < 4; ++j) \
                acc[i][4 * (jh) + j] = __builtin_amdgcn_mfma_f32_16x16x32_bf16(av[i], bv[j], acc[i][4 * (jh) + j], 0, 0, 0); } while (0)
            {
                bf16x8 aX[4], aY[4], bX[4], bY[4];
                G1_RA(aX, 0); G1_RB(bX, 0, 0);
                __builtin_amdgcn_sched_barrier(0);
                G1_RB(bY, 0, 1); G1_MM(aX, bX, 0);
                __builtin_amdgcn_sched_barrier(0);
                G1_RA(aY, 1); G1_RB(bX, 1, 0); G1_MM(aX, bY, 1);
                __builtin_amdgcn_sched_barrier(0);
                G1_RB(bY, 1, 1); G1_MM(aY, bX, 0);
                __builtin_amdgcn_sched_barrier(0);
                G1_MM(aY, bY, 1);
            }
#undef G1_RA
#undef G1_RB
#undef G1_MM
            __syncthreads();
        }
        const int nb = n0 + wn * 64;
        int le_ = lane; asm volatile("" : "+v"(le_));
        const int l15e = le_ & 15, q4e = le_ >> 4;
#pragma unroll
        for (int b = 0; b < 8; ++b) {
            const int m = m0 + wm * 128 + b * 16 + l15e;
            float sc[16];
#pragma unroll
            for (int e = 0; e < 16; ++e) sc[e] = acc[e >> 2][b][e & 3];
            if (nb >= NP) {
                u32x4 o0, o1;
                o0.x = pack2(sigmoidf_(sc[0]), sigmoidf_(sc[1])); o0.y = pack2(sigmoidf_(sc[2]), sigmoidf_(sc[3]));
                o0.z = pack2(sigmoidf_(sc[4]), sigmoidf_(sc[5])); o0.w = pack2(sigmoidf_(sc[6]), sigmoidf_(sc[7]));
                o1.x = pack2(sigmoidf_(sc[8]), sigmoidf_(sc[9])); o1.y = pack2(sigmoidf_(sc[10]), sigmoidf_(sc[11]));
                o1.z = pack2(sigmoidf_(sc[12]), sigmoidf_(sc[13])); o1.w = pack2(sigmoidf_(sc[14]), sigmoidf_(sc[15]));
                bf16_t* dst = G + (size_t)m * 2048 + (nb - NP) + 16 * q4e;
                *(u32x4*)dst = o0; *(u32x4*)(dst + 8) = o1;
            } else {
                if (nb >= C_Q && nb < C_AV) {
                    float ss = 0.f;
#pragma unroll
                    for (int e = 0; e < 16; ++e) ss += sc[e] * sc[e];
                    ss += __shfl_xor(ss, 16);
                    ss += __shfl_xor(ss, 32);
                    const float rs = rsqrtf(ss * (1.f / 64.f) + 1e-6f) * ((nb < C_AK) ? 0.125f : 1.0f);
                    const float* gain = (nb < C_AK) ? a.q_gain : a.k_gain;
#pragma unroll
                    for (int e = 0; e < 16; ++e) sc[e] = sc[e] * rs * gain[16 * q4e + e];
                }
                if (nb >= C_AK && nb < C_GB) {
                    const int isv = nb >= C_AV;
                    const int head = (nb - (isv ? C_AV : C_AK)) >> 6;
                    unsigned char* rowb = a.ws + WS_KV + (size_t)m * 1024 + (isv ? 8 : 0);
#pragma unroll
                    for (int hf8 = 0; hf8 < 2; ++hf8) {
                        const int u = 8 * (2 * q4e + hf8) + head;
                        unsigned w0 = __builtin_amdgcn_cvt_pk_fp8_f32(sc[8 * hf8 + 0], sc[8 * hf8 + 1], 0, false);
                        w0 = __builtin_amdgcn_cvt_pk_fp8_f32(sc[8 * hf8 + 2], sc[8 * hf8 + 3], w0, true);
                        unsigned w1 = __builtin_amdgcn_cvt_pk_fp8_f32(sc[8 * hf8 + 4], sc[8 * hf8 + 5], 0, false);
                        w1 = __builtin_amdgcn_cvt_pk_fp8_f32(sc[8 * hf8 + 6], sc[8 * hf8 + 7], w1, true);
                        *(u32x2*)(rowb + 16 * u) = (u32x2){w0, w1};
                    }
                } else {
                    u32x4 o0, o1;
                    o0.x = pack2(sc[0], sc[1]); o0.y = pack2(sc[2], sc[3]); o0.z = pack2(sc[4], sc[5]); o0.w = pack2(sc[6], sc[7]);
                    o1.x = pack2(sc[8], sc[9]); o1.y = pack2(sc[10], sc[11]); o1.z = pack2(sc[12], sc[13]); o1.w = pack2(sc[14], sc[15]);
                    bf16_t* dst = P + (size_t)m * NP + nb + 16 * q4e;
                    *(u32x4*)dst = o0; *(u32x4*)(dst + 8) = o1;
                }
            }
        }
    }
}

__device__ __forceinline__ bf16x8 ldfrag(const unsigned char* arr, int row, int ks, int hi) { return *(const bf16x8*)(arr + swz128(row, 2 * ks + hi)); }
__device__ __forceinline__ f32x16 mm_tile(const unsigned char* Aarr, int arow0, const unsigned char* Barr, int brow0, int l31, int hi, f32x16 acc) {
#pragma unroll
    for (int ks = 0; ks < 4; ++ks) acc = __builtin_amdgcn_mfma_f32_32x32x16_bf16(ldfrag(Aarr, arow0 + l31, ks, hi), ldfrag(Barr, brow0 + l31, ks, hi), acc, 0, 0, 0);
    return acc;
}
__device__ __forceinline__ int rowmap(int r, int hi) { return (r & 3) + 8 * (r >> 2) + 4 * hi; }
__device__ __forceinline__ void store_lane_major(unsigned char* arr, const f32x16& acc, int irow0, int t, int hi, int incl) {
#pragma unroll
    for (int q = 0; q < 4; ++q) {
        float v[4];
#pragma unroll
        for (int e = 0; e < 4; ++e) { const int i = irow0 + 8 * q + 4 * hi + e; v[e] = (i < t + incl) ? acc[4 * q + e] : 0.f; }
        u32x2 o; o.x = pack2(v[0], v[1]); o.y = pack2(v[2], v[3]);
        *(u32x2*)(arr + swz128(t, (irow0 >> 3) + q) + 8 * hi) = o;
    }
}
__device__ __forceinline__ void load_shift16(const bf16_t* P, int tglob, int col, const float* mu, float (&out)[16]) {
    const bf16_t* pc = P + (size_t)tglob * NP + col;
    const u32x4 c0 = *(const u32x4*)pc, c1 = *(const u32x4*)(pc + 8);
    u32x4 p0 = (u32x4){0u, 0u, 0u, 0u}, p1 = p0;
    if (tglob > 0) { p0 = *(const u32x4*)(pc - NP); p1 = *(const u32x4*)(pc - NP + 8); }
    const unsigned cw[8] = {c0.x, c0.y, c0.z, c0.w, c1.x, c1.y, c1.z, c1.w};
    const unsigned pw[8] = {p0.x, p0.y, p0.z, p0.w, p1.x, p1.y, p1.z, p1.w};
#pragma unroll
    for (int e = 0; e < 8; ++e) {
        const float ca = lo2f(cw[e]), cb = hi2f(cw[e]), pa = lo2f(pw[e]), pb = hi2f(pw[e]);
        out[2 * e] = ca + mu[col + 2 * e] * (pa - ca);
        out[2 * e + 1] = cb + mu[col + 2 * e + 1] * (pb - cb);
    }
}
__device__ __forceinline__ void half_solve(const float* NBT, int base, float (&x)[32]) {
#pragma unroll
    for (int i = 0; i < 31; ++i) {
        const float xi = x[i];
        int z; asm("v_mov_b32 %0, 0 ; after %1" : "=v"(z) : "v"(x[i > 3 ? i - 4 : 0]));
        const float* ncol = NBT + (base + i) * 64 + base + z;
#pragma unroll
        for (int g4 = (i + 1) / 4; g4 < 8; ++g4) {
            const f32x4 n = *(const f32x4*)(ncol + 4 * g4);
            if (4 * g4 + 0 > i) x[4 * g4 + 0] += n.x * xi;
            if (4 * g4 + 1 > i) x[4 * g4 + 1] += n.y * xi;
            if (4 * g4 + 2 > i) x[4 * g4 + 2] += n.z * xi;
            if (4 * g4 + 3 > i) x[4 * g4 + 3] += n.w * xi;
        }
    }
}
__device__ __forceinline__ void tri_solve(const float* NBT, unsigned char* rhs, unsigned char* outT, unsigned char* nsw, bf16_t* gp) {
    int t_ = threadIdx.x; asm volatile("" : "+v"(t_));
    const int lane = t_ & 63, l31 = lane & 31, hi = lane >> 5;
    {
        float v[16];
#pragma unroll
        for (int e = 0; e < 16; ++e) v[e] = NBT[(16 * hi + e) * 64 + 32 + l31];
        u32x4 o0, o1;
        o0.x = pack2(v[0], v[1]); o0.y = pack2(v[2], v[3]); o0.z = pack2(v[4], v[5]); o0.w = pack2(v[6], v[7]);
        o1.x = pack2(v[8], v[9]); o1.y = pack2(v[10], v[11]); o1.z = pack2(v[12], v[13]); o1.w = pack2(v[14], v[15]);
        *(u32x4*)(nsw + l31 * 64 + hi * 32) = o0; *(u32x4*)(nsw + l31 * 64 + hi * 32 + 16) = o1;
    }
    float x[32];
#pragma unroll
    for (int t = 0; t < 32; ++t) x[t] = bf2f(*(const bf16_t*)(rhs + (t * 64 + lane) * 2));
    half_solve(NBT, 0, x);
#pragma unroll
    for (int c = 0; c < 4; ++c) {
        u32x4 o; o.x = pack2(x[8 * c], x[8 * c + 1]); o.y = pack2(x[8 * c + 2], x[8 * c + 3]); o.z = pack2(x[8 * c + 4], x[8 * c + 5]); o.w = pack2(x[8 * c + 6], x[8 * c + 7]);
        *(u32x4*)(outT + swz128(lane, c)) = o;
    }
#pragma unroll
    for (int t = 0; t < 32; ++t) gp[(size_t)t * NP + lane] = f2bf(x[t]);
    wave_lds_sync();
#pragma unroll
    for (int tile = 0; tile < 2; ++tile) {
        f32x16 acc = zero16();
#pragma unroll
        for (int ks = 0; ks < 2; ++ks)
            acc = __builtin_amdgcn_mfma_f32_32x32x16_bf16(*(const bf16x8*)(nsw + l31 * 64 + (2 * ks + hi) * 16), ldfrag(outT, 32 * tile + l31, ks, hi), acc, 0, 0, 0);
#pragma unroll
        for (int r = 0; r < 16; ++r) {
            bf16_t* p = (bf16_t*)(rhs + ((32 + rowmap(r, hi)) * 64 + 32 * tile + l31) * 2);
            *p = f2bf(bf2f(*p) + acc[r]);
        }
    }
    wave_lds_sync();
#pragma unroll
    for (int t = 0; t < 32; ++t) x[t] = bf2f(*(const bf16_t*)(rhs + ((32 + t) * 64 + lane) * 2));
    half_solve(NBT, 32, x);
#pragma unroll
    for (int c = 0; c < 4; ++c) {
        u32x4 o; o.x = pack2(x[8 * c], x[8 * c + 1]); o.y = pack2(x[8 * c + 2], x[8 * c + 3]); o.z = pack2(x[8 * c + 4], x[8 * c + 5]); o.w = pack2(x[8 * c + 6], x[8 * c + 7]);
        *(u32x4*)(outT + swz128(lane, 4 + c)) = o;
    }
#pragma unroll
    for (int t = 0; t < 32; ++t) gp[(size_t)(32 + t) * NP + lane] = f2bf(x[t]);
}

constexpr int RO_AT = 0, RO_RT = 8192  , RO_KT = 16384, RO_BT = 24576, RO_VT = 32768, RO_ST = 40960  ;
constexpr int RO_NB = 16384;
constexpr int RO_AAK = 49152;
constexpr int RO_X1 = 57344  , RO_WTT = 49152  , RO_U0T = 73728;
constexpr int RO_NSW = 0;
constexpr int RO_ARB = 57344, RO_ARK = 16384  , RO_WP = 0  , RO_U0P = 65536  ;
constexpr int RO_UT = 49152;
constexpr int RO_Y = 16384;
constexpr int RO_TW = 0, RO_TA = 8192, RO_WL = 16384, RO_AL = 32768, RO_LWL = 49152, RO_QT = 73728, RO_APL = 65536  ;

template <int PASS>
__device__ __forceinline__ void phase_rwkv_chunk(const Args& a, unsigned char* lds, int wg, int nwg) {
    for (int chunk = wg; chunk < 256; chunk += nwg) {
#pragma unroll 1
        for (int rd = 0; rd < 4; ++rd) {
            unsigned char* wsb = a.ws; asm volatile("" : "+s"(wsb));
            const bf16_t* P = (const bf16_t*)(wsb + WS_P);
            const bf16_t* WupT = (const bf16_t*)(wsb + WS_WUPT);
            const bf16_t* AupT = (const bf16_t*)(wsb + WS_AUPT);
            float* GLg = (float*)(wsb + WS_GL);
            unsigned char* RMg = wsb + WS_RM;
            unsigned char* RCg = wsb + WS_RC;
            bf16_t* YA = (bf16_t*)(wsb + WS_YA);
            int tid = threadIdx.x; asm volatile("" : "+v"(tid));
            const int wv = __builtin_amdgcn_readfirstlane((int)(threadIdx.x >> 6));
            const int g = wv >> 2, w4 = wv & 3, lt = tid & 255, lane = tid & 63, l31 = lane & 31, hi = lane >> 5;
            unsigned char* R = lds + g * 81920;
            const int et = lt >> 2, ec0 = 16 * (lt & 3);
            const int ta = w4 >> 1, tb = w4 & 1;
            const int h = 2 * rd + g, t0 = chunk * 64, colh = 64 * h, item = chunk * 8 + h;
            __syncthreads();
            float k_s[16];
            load_shift16(P, t0 + et, C_K + colh + ec0, a.mu, k_s);
            {
                float tmp[16];
                load_shift16(P, t0 + et, C_WD + ec0, a.mu, tmp);
                u32x4 o0, o1;
                o0.x = pack2(tanhf_(tmp[0]), tanhf_(tmp[1])); o0.y = pack2(tanhf_(tmp[2]), tanhf_(tmp[3])); o0.z = pack2(tanhf_(tmp[4]), tanhf_(tmp[5])); o0.w = pack2(tanhf_(tmp[6]), tanhf_(tmp[7]));
                o1.x = pack2(tanhf_(tmp[8]), tanhf_(tmp[9])); o1.y = pack2(tanhf_(tmp[10]), tanhf_(tmp[11])); o1.z = pack2(tanhf_(tmp[12]), tanhf_(tmp[13])); o1.w = pack2(tanhf_(tmp[14]), tanhf_(tmp[15]));
                *(u32x4*)(R + RO_TW + swz128(et, ec0 >> 3)) = o0; *(u32x4*)(R + RO_TW + swz128(et, (ec0 >> 3) + 1)) = o1;
                load_shift16(P, t0 + et, C_AD + ec0, a.mu, tmp);
                o0.x = pack2(tmp[0], tmp[1]); o0.y = pack2(tmp[2], tmp[3]); o0.z = pack2(tmp[4], tmp[5]); o0.w = pack2(tmp[6], tmp[7]);
                o1.x = pack2(tmp[8], tmp[9]); o1.y = pack2(tmp[10], tmp[11]); o1.z = pack2(tmp[12], tmp[13]); o1.w = pack2(tmp[14], tmp[15]);
                *(u32x4*)(R + RO_TA + swz128(et, ec0 >> 3)) = o0; *(u32x4*)(R + RO_TA + swz128(et, (ec0 >> 3) + 1)) = o1;
            }
            __syncthreads();
            {
                f32x16 accw = zero16(), acca = zero16();
                const bf16_t* wp = WupT + (size_t)(colh + 32 * tb + l31) * 64 + 8 * hi;
                const bf16_t* ap = AupT + (size_t)(colh + 32 * tb + l31) * 64 + 8 * hi;
#pragma unroll
                for (int ks = 0; ks < 4; ++ks) {
                    accw = __builtin_amdgcn_mfma_f32_32x32x16_bf16(ldfrag(R + RO_TW, 32 * ta + l31, ks, hi), *(const bf16x8*)(wp + 16 * ks), accw, 0, 0, 0);
                    acca = __builtin_amdgcn_mfma_f32_32x32x16_bf16(ldfrag(R + RO_TA, 32 * ta + l31, ks, hi), *(const bf16x8*)(ap + 16 * ks), acca, 0, 0, 0);
                }
                float* WL = (float*)(R + RO_WL); float* AL = (float*)(R + RO_AL);
#pragma unroll
                for (int r = 0; r < 16; ++r) { const int t = 32 * ta + rowmap(r, hi); WL[t * 64 + 32 * tb + l31] = accw[r]; AL[t * 64 + 32 * tb + l31] = acca[r]; }
            }
            __syncthreads();
            float lw[16], kk[16], av[16], kbar[16];
            float bonus = 0.f;
            {
                float r_s[16];
                if (PASS == 2) load_shift16(P, t0 + et, C_R + colh + ec0, a.mu, r_s);
                const float* WL = (const float*)(R + RO_WL); const float* AL = (const float*)(R + RO_AL);
                float ss = 0.f;
#pragma unroll
                for (int e = 0; e < 16; ++e) {
                    const int c = colh + ec0 + e;
                    const float wl = WL[et * 64 + ec0 + e], al = AL[et * 64 + ec0 + e];
                    lw[e] = -0.606531f / (1.f + __expf(-(a.w0[c] + wl)));
                    av[e] = 1.f / (1.f + __expf(-(a.a0[c] + al)));
                    kk[e] = k_s[e] * a.k_k[c];
                    ss += kk[e] * kk[e];
                    kbar[e] = k_s[e] * (1.f + (av[e] - 1.f) * a.k_a[c]);
                    if (PASS == 2) bonus += r_s[e] * kbar[e] * a.r_k[c];
                }
                ss = sum4_dpp(ss);
                if (PASS == 2) bonus = sum4_dpp(bonus);
                const float inv = 1.f / fmaxf(sqrtf(ss), 1e-12f);
                float* LWL = (float*)(R + RO_LWL);
#pragma unroll
                for (int e = 0; e < 16; ++e) { kk[e] *= inv; LWL[et * 64 + ec0 + e] = lw[e]; }
            }
            __syncthreads();
            {
                float* LWL = (float*)(R + RO_LWL); float* QT = (float*)(R + RO_QT);
                const int col = lt & 63, qtr = lt >> 6;
                float s = 0.f;
#pragma unroll
                for (int i = 0; i < 16; ++i) { s += LWL[(16 * qtr + i) * 64 + col]; LWL[(16 * qtr + i) * 64 + col] = s; }
                QT[qtr * 64 + col] = s;
            }
            __syncthreads();
            {
                const float* LWL = (const float*)(R + RO_LWL); const float* QT = (const float*)(R + RO_QT);
                const int qtr = et >> 4;
                float r_s[16], v_s[16];
                load_shift16(P, t0 + et, C_V + colh + ec0, a.mu, v_s);
                if (PASS == 2) load_shift16(P, t0 + et, C_R + colh + ec0, a.mu, r_s);
#pragma unroll
                for (int hlf = 0; hlf < 2; ++hlf) {
                    float at_[8], kt_[8], bt_[8], rt_[8];
#pragma unroll
                    for (int e8 = 0; e8 < 8; ++e8) {
                        const int e = 8 * hlf + e8, col = ec0 + e;
                        const float q0 = QT[col], q1 = QT[64 + col], q2 = QT[128 + col], q3 = QT[192 + col];
                        const float off = (qtr > 0 ? q0 : 0.f) + (qtr > 1 ? q1 : 0.f) + (qtr > 2 ? q2 : 0.f);
                        const float Lt = LWL[et * 64 + col] + off, Lend = (q0 + q1) + (q2 + q3);
                        const float ep = __expf(Lt), em = __expf(-Lt), epv = __expf(Lt - lw[e]), eend = __expf(Lend - Lt);
                        at_[e8] = -kk[e] * epv; kt_[e8] = kbar[e] * em; bt_[e8] = kk[e] * av[e] * em; rt_[e8] = r_s[e] * ep;
                        const int toff = swz128(col, et >> 3) + (et & 7) * 2;
                        *(bf16_t*)(R + RO_VT + toff) = f2bf(v_s[e]);
                        if (PASS == 1) {
                            *(bf16_t*)(R + RO_RT + toff) = f2bf(kk[e] * av[e] * eend);
                            *(bf16_t*)(R + RO_ST + toff) = f2bf(kbar[e] * eend);
                            if (et == 63) GLg[(size_t)item * 64 + col] = __expf(Lend);
                        }
                    }
                    u32x4 o;
                    const int ch = (ec0 >> 3) + hlf;
                    o.x = pack2(at_[0], at_[1]); o.y = pack2(at_[2], at_[3]); o.z = pack2(at_[4], at_[5]); o.w = pack2(at_[6], at_[7]);
                    if (PASS == 1) { *(u32x4*)(R + RO_AT + swz128(et, ch)) = o; *(u32x4*)(R + RO_APL + (et * 64 + ec0 + 8 * hlf) * 2) = o; }
                    o.x = pack2(kt_[0], kt_[1]); o.y = pack2(kt_[2], kt_[3]); o.z = pack2(kt_[4], kt_[5]); o.w = pack2(kt_[6], kt_[7]);
                    *(u32x4*)(R + RO_KT + swz128(et, ch)) = o;
                    o.x = pack2(bt_[0], bt_[1]); o.y = pack2(bt_[2], bt_[3]); o.z = pack2(bt_[4], bt_[5]); o.w = pack2(bt_[6], bt_[7]);
                    *(u32x4*)(R + RO_BT + swz128(et, ch)) = o;
                    if (PASS == 2) {
                        o.x = pack2(rt_[0], rt_[1]); o.y = pack2(rt_[2], rt_[3]); o.z = pack2(rt_[4], rt_[5]); o.w = pack2(rt_[6], rt_[7]);
                        *(u32x4*)(R + RO_RT + swz128(et, ch)) = o;
                    }
                }
                if (PASS == 2) {
#pragma unroll
                    for (int i = 0; i < 2; ++i) {
                        const int cid = lt + 256 * i, row = cid >> 3, kc = cid & 7;
                        u32x4 sv = (u32x4){0u, 0u, 0u, 0u};
                        if (chunk > 0) sv = *(const u32x4*)(RCg + (size_t)(item - 8) * 8192 + row * 128 + kc * 16);
                        *(u32x4*)(R + RO_ST + swz128(row, kc)) = sv;
                        *(u32x4*)(R + RO_WP + swz128(row, kc)) = *(const u32x4*)(P + (size_t)(t0 + row) * NP + C_AK + colh + kc * 8);
                        *(u32x4*)(R + RO_U0P + row * 128 + kc * 16) = *(const u32x4*)(P + (size_t)(t0 + row) * NP + C_AV + colh + kc * 8);
                    }
                }
            }
            __syncthreads();
            {
                f32x16 accN = zero16(), accAak = zero16(), accArb = zero16(), accArk = zero16(), accU = zero16();
                if (ta <= tb) {
                    if (PASS == 1) {
                        accN = mm_tile(R + RO_BT, 32 * ta, R + RO_AT, 32 * tb, l31, hi, accN);
                        accAak = mm_tile(R + RO_KT, 32 * ta, R + RO_AT, 32 * tb, l31, hi, accAak);
                    } else {
                        accArb = mm_tile(R + RO_BT, 32 * ta, R + RO_RT, 32 * tb, l31, hi, accArb);
                        accArk = mm_tile(R + RO_KT, 32 * ta, R + RO_RT, 32 * tb, l31, hi, accArk);
                    }
                }
                if (PASS == 2) accU = mm_tile(R + RO_WP, 32 * ta, R + RO_ST, 32 * tb, l31, hi, accU);
                __syncthreads();
                if (PASS == 1) {
                    float* NB = (float*)(R + RO_NB);
#pragma unroll
                    for (int r = 0; r < 16; ++r) { const int i = 32 * ta + rowmap(r, hi), t = 32 * tb + l31; NB[i * 64 + t] = (i < t) ? accN[r] : 0.f; }
                    store_lane_major(R + RO_AAK, accAak, 32 * ta, 32 * tb + l31, hi, 0);
                } else {
                    store_lane_major(R + RO_ARB, accArb, 32 * ta, 32 * tb + l31, hi, 1);
                    store_lane_major(R + RO_ARK, accArk, 32 * ta, 32 * tb + l31, hi, 1);
#pragma unroll
                    for (int r = 0; r < 16; ++r) accU[r] += bf2f(*(const bf16_t*)(R + RO_U0P + ((32 * ta + rowmap(r, hi)) * 64 + 32 * tb + l31) * 2));
                    store_lane_major(R + RO_UT, accU, 32 * ta, 32 * tb + l31, hi, 64);
                }
            }
            __syncthreads();
            if (PASS == 1) {
                {
                    f32x16 acc = zero16();
                    acc = mm_tile(R + RO_AAK, 32 * ta, R + RO_VT, 32 * tb, l31, hi, acc);
#pragma unroll
                    for (int r = 0; r < 16; ++r) { const int t = 32 * ta + rowmap(r, hi); *(bf16_t*)(R + RO_X1 + (t * 64 + 32 * tb + l31) * 2) = f2bf(acc[r]); }
                }
                __syncthreads();
                if (w4 < 2) tri_solve((const float*)(R + RO_NB), R + (w4 ? RO_X1 : RO_APL), R + (w4 ? RO_U0T : RO_WTT), R + RO_NSW + 2048 * w4,
                                      (bf16_t*)(wsb + WS_P) + (size_t)t0 * NP + (w4 ? C_AV : C_AK) + colh);
                __syncthreads();
                int tid3 = threadIdx.x; asm volatile("" : "+v"(tid3));
                const int lane = tid3 & 63, l31 = lane & 31, hi = lane >> 5;
                {
                    f32x16 acc = zero16();
                    acc = mm_tile(R + RO_WTT, 32 * ta, R + RO_RT, 32 * tb, l31, hi, acc);
                    if (ta == tb) {
                        const float g63 = GLg[(size_t)item * 64 + 32 * tb + l31];
#pragma unroll
                        for (int r = 0; r < 16; ++r) if (rowmap(r, hi) == l31) acc[r] += g63;
                    }
                    unsigned char* mp = RMg + (size_t)item * 8192 + ((size_t)((tb * 2 + ta) * 2) * 64 + lane) * 16;
                    u32x4 o;
                    o.x = pack2(acc[0], acc[1]); o.y = pack2(acc[2], acc[3]); o.z = pack2(acc[4], acc[5]); o.w = pack2(acc[6], acc[7]);
                    *(u32x4*)mp = o;
                    o.x = pack2(acc[8], acc[9]); o.y = pack2(acc[10], acc[11]); o.z = pack2(acc[12], acc[13]); o.w = pack2(acc[14], acc[15]);
                    *(u32x4*)(mp + 64 * 16) = o;
                }
                {
                    f32x16 acc = zero16();
                    acc = mm_tile(R + RO_RT, 32 * ta, R + RO_U0T, 32 * tb, l31, hi, acc);
                    acc = mm_tile(R + RO_ST, 32 * ta, R + RO_VT, 32 * tb, l31, hi, acc);
                    unsigned char* cp = RCg + (size_t)item * 8192 + ((size_t)(tb * 2 + ta) * 64 + lane) * 32;
                    u32x4 o;
                    o.x = pack2(acc[0], acc[1]); o.y = pack2(acc[2], acc[3]); o.z = pack2(acc[4], acc[5]); o.w = pack2(acc[6], acc[7]);
                    *(u32x4*)cp = o;
                    o.x = pack2(acc[8], acc[9]); o.y = pack2(acc[10], acc[11]); o.z = pack2(acc[12], acc[13]); o.w = pack2(acc[14], acc[15]);
                    *(u32x4*)(cp + 16) = o;
                }
            } else {
                int tid2 = threadIdx.x; asm volatile("" : "+v"(tid2));
                const int lane = tid2 & 63, l31 = lane & 31, hi = lane >> 5, lt = tid2 & 255, et = lt >> 2, ec0 = 16 * (lt & 3);
                {
                    f32x16 acc = zero16();
                    acc = mm_tile(R + RO_RT, 32 * ta, R + RO_ST, 32 * tb, l31, hi, acc);
                    acc = mm_tile(R + RO_ARB, 32 * ta, R + RO_UT, 32 * tb, l31, hi, acc);
                    acc = mm_tile(R + RO_ARK, 32 * ta, R + RO_VT, 32 * tb, l31, hi, acc);
                    __syncthreads();
                    float* Y = (float*)(R + RO_Y);
#pragma unroll
                    for (int r = 0; r < 16; ++r) { const int t = 32 * ta + rowmap(r, hi); Y[t * 64 + 32 * tb + l31] = acc[r]; }
                }
                __syncthreads();
                {
                    const float* Y = (const float*)(R + RO_Y);
                    float g_s[16], v_e[16];
                    load_shift16(P, t0 + et, C_G + colh + ec0, a.mu, g_s);
                    load_shift16(P, t0 + et, C_V + colh + ec0, a.mu, v_e);
                    float y[16], s = 0.f;
#pragma unroll
                    for (int e = 0; e < 16; ++e) { y[e] = Y[et * 64 + ec0 + e]; s += y[e]; }
                    s = sum4_dpp(s);
                    const float mean = s * (1.f / 64.f);
                    float q = 0.f;
#pragma unroll
                    for (int e = 0; e < 16; ++e) { const float d = y[e] - mean; q += d * d; }
                    q = sum4_dpp(q);
                    const float rstd = rsqrtf(q * (1.f / 64.f) + 64e-5f);
                    float o[16];
#pragma unroll
                    for (int e = 0; e < 16; ++e) {
                        const int c = colh + ec0 + e;
                        const float yn = (y[e] - mean) * rstd * a.gn_w[c] + a.gn_b[c];
                        o[e] = (yn + bonus * v_e[e]) * (g_s[e] / (1.f + __expf(-g_s[e])));
                    }
                    u32x4 o0, o1;
                    o0.x = pack2(o[0], o[1]); o0.y = pack2(o[2], o[3]); o0.z = pack2(o[4], o[5]); o0.w = pack2(o[6], o[7]);
                    o1.x = pack2(o[8], o[9]); o1.y = pack2(o[10], o[11]); o1.z = pack2(o[12], o[13]); o1.w = pack2(o[14], o[15]);
                    bf16_t* dst = YA + (size_t)(t0 + et) * 512 + colh + ec0;
                    *(u32x4*)dst = o0; *(u32x4*)(dst + 8) = o1;
                }
            }
        }
    }
}

struct ScanBuf { u32x4 m[8], c[4]; };
__device__ __forceinline__ void scan_prefetch(ScanBuf& b, const unsigned char* RMg, const unsigned char* RCg, int c, int h, int vh, int lane) {
    const int item = (c < 256 ? c : 255) * 8 + h;
    const unsigned char* mp = RMg + (size_t)item * 8192 + (size_t)lane * 16;
#pragma unroll
    for (int i = 0; i < 8; ++i) b.m[i] = *(const u32x4*)(mp + (size_t)i * 64 * 16);
#pragma unroll
    for (int kt = 0; kt < 2; ++kt) {
        const unsigned char* cp = RCg + (size_t)item * 8192 + ((size_t)(vh * 2 + kt) * 64 + lane) * 32;
        b.c[2 * kt] = *(const u32x4*)cp; b.c[2 * kt + 1] = *(const u32x4*)(cp + 16);
    }
}
__device__ __forceinline__ void scan_step(const ScanBuf& b, f32x16 (&X)[2], unsigned char* RCg, int c, int h, int vh, int l31, int hi) {
    bf16x8 bfr[2][2];
#pragma unroll
    for (int kt = 0; kt < 2; ++kt)
#pragma unroll
        for (int s = 0; s < 2; ++s) {
            u32x4 w;
            w.x = pack2(X[kt][8 * s + 0], X[kt][8 * s + 1]); w.y = pack2(X[kt][8 * s + 2], X[kt][8 * s + 3]);
            w.z = pack2(X[kt][8 * s + 4], X[kt][8 * s + 5]); w.w = pack2(X[kt][8 * s + 6], X[kt][8 * s + 7]);
            bfr[kt][s] = __builtin_bit_cast(bf16x8, w);
        }
#pragma unroll
    for (int kp = 0; kp < 2; ++kp) {
        f32x16 acc;
        const unsigned cw[8] = {b.c[2 * kp].x, b.c[2 * kp].y, b.c[2 * kp].z, b.c[2 * kp].w, b.c[2 * kp + 1].x, b.c[2 * kp + 1].y, b.c[2 * kp + 1].z, b.c[2 * kp + 1].w};
#pragma unroll
        for (int e = 0; e < 8; ++e) { acc[2 * e] = lo2f(cw[e]); acc[2 * e + 1] = hi2f(cw[e]); }
#pragma unroll
        for (int kt = 0; kt < 2; ++kt)
#pragma unroll
            for (int s = 0; s < 2; ++s) acc = __builtin_amdgcn_mfma_f32_32x32x16_bf16(__builtin_bit_cast(bf16x8, b.m[(kp * 2 + kt) * 2 + s]), bfr[kt][s], acc, 0, 0, 0);
        X[kp] = acc;
    }
    unsigned char* sp = RCg + (size_t)(c * 8 + h) * 8192 + (size_t)(32 * vh + l31) * 128;
#pragma unroll
    for (int kp = 0; kp < 2; ++kp)
#pragma unroll
        for (int q = 0; q < 4; ++q) {
            u32x2 o; o.x = pack2(X[kp][4 * q], X[kp][4 * q + 1]); o.y = pack2(X[kp][4 * q + 2], X[kp][4 * q + 3]);
            *(u32x2*)(sp + (32 * kp + 8 * q + 4 * hi) * 2) = o;
        }
}
__device__ __forceinline__ void phase_rwkv_scan(const Args& a, int wg) {
    if (wg >= 8 || threadIdx.x >= 128) return;
    int lane_ = threadIdx.x; asm volatile("" : "+v"(lane_));
    const int h = wg, vh = __builtin_amdgcn_readfirstlane(lane_ >> 6), lane = lane_ & 63, l31 = lane & 31, hi = lane >> 5;
    const unsigned char* RMg = a.ws + WS_RM;
    unsigned char* RCg = a.ws + WS_RC;
    f32x16 X[2] = {zero16(), zero16()};
    ScanBuf b0, b1, b2;
    scan_prefetch(b0, RMg, RCg, 0, h, vh, lane);
    scan_prefetch(b1, RMg, RCg, 1, h, vh, lane);
    scan_prefetch(b2, RMg, RCg, 2, h, vh, lane);
    for (int c = 0; c < 255; c += 3) {
        scan_step(b0, X, RCg, c, h, vh, l31, hi);     scan_prefetch(b0, RMg, RCg, c + 3, h, vh, lane);
        scan_step(b1, X, RCg, c + 1, h, vh, l31, hi); scan_prefetch(b1, RMg, RCg, c + 4, h, vh, lane);
        scan_step(b2, X, RCg, c + 2, h, vh, l31, hi); scan_prefetch(b2, RMg, RCg, c + 5, h, vh, lane);
    }
    scan_step(b0, X, RCg, 255, h, vh, l31, hi);
}

__device__ __forceinline__ float max8_dpp(float v) { v = fmaxf(v, dppf<0xB1>(v)); v = fmaxf(v, dppf<0x4E>(v)); v = fmaxf(v, dppf<0x141>(v)); return v; }

__device__ __forceinline__ void attn_query(const bf16_t* P, const unsigned char* KV, bf16_t* YB, int t, int cnt, const unsigned short* sl, float* rw, int lane) {
    const int h = lane & 7, j = lane >> 3;
    {
        const int per = cnt >> 3;
        f32x2 q2[32];
        {
            const float L2E = 1.44269504089f;
#pragma unroll
            for (int c = 0; c < 8; ++c) {
                const u32x4 qr = *(const u32x4*)(P + (size_t)t * NP + C_Q + 64 * h + 8 * c);
                q2[4 * c + 0] = (f32x2){lo2f(qr.x) * L2E, hi2f(qr.x) * L2E}; q2[4 * c + 1] = (f32x2){lo2f(qr.y) * L2E, hi2f(qr.y) * L2E};
                q2[4 * c + 2] = (f32x2){lo2f(qr.z) * L2E, hi2f(qr.z) * L2E}; q2[4 * c + 3] = (f32x2){lo2f(qr.w) * L2E, hi2f(qr.w) * L2E};
            }
        }
        const unsigned short* myk = sl + j * per;
        float m = -INFINITY, l = 0.f;
        f32x2 acc[32];
#pragma unroll
        for (int d = 0; d < 32; ++d) acc[d] = (f32x2){0.f, 0.f};
        const unsigned char* kvb = KV + 16 * h;
        u32x4 kA[8], kB[8];
#define AT_LOAD(dst, keyv) do { const unsigned char* p_ = kvb + (size_t)(keyv) * 1024; _Pragma("unroll") for (int i = 0; i < 8; ++i) \
            asm volatile("global_load_dwordx4 %0, %1, off offset:%2" : "=v"(dst[i]) : "v"(p_), "n"(128 * i) : "memory"); } while (0)
#define AT_WAIT(dst) asm volatile("s_waitcnt vmcnt(8)" : "+v"(dst[0]), "+v"(dst[1]), "+v"(dst[2]), "+v"(dst[3]), "+v"(dst[4]), "+v"(dst[5]), "+v"(dst[6]), "+v"(dst[7]) :: "memory")
#define AT_STEP(kv) do { \
            f32x2 d0 = (f32x2){0.f, 0.f}, d1 = (f32x2){0.f, 0.f}; \
            _Pragma("unroll") for (int i = 0; i < 8; ++i) { \
                d0 = q2[4 * i + 0] * __builtin_amdgcn_cvt_pk_f32_fp8(kv[i].x, false) + d0; d1 = q2[4 * i + 1] * __builtin_amdgcn_cvt_pk_f32_fp8(kv[i].x, true) + d1; \
                d0 = q2[4 * i + 2] * __builtin_amdgcn_cvt_pk_f32_fp8(kv[i].y, false) + d0; d1 = q2[4 * i + 3] * __builtin_amdgcn_cvt_pk_f32_fp8(kv[i].y, true) + d1; } \
            const float dot = (d0.x + d0.y) + (d1.x + d1.y); \
            if (dot > m + 8.f) {              \
                const float scl = __builtin_amdgcn_exp2f(m - dot); l *= scl; \
                _Pragma("unroll") for (int d = 0; d < 32; ++d) acc[d] = acc[d] * scl; \
                m = dot; } \
            const float p = __builtin_amdgcn_exp2f(dot - m); l += p; \
            const f32x2 pp = (f32x2){p, p}; \
            _Pragma("unroll") for (int i = 0; i < 8; ++i) { \
                acc[4 * i + 0] = __builtin_amdgcn_cvt_pk_f32_fp8(kv[i].z, false) * pp + acc[4 * i + 0]; acc[4 * i + 1] = __builtin_amdgcn_cvt_pk_f32_fp8(kv[i].z, true) * pp + acc[4 * i + 1]; \
                acc[4 * i + 2] = __builtin_amdgcn_cvt_pk_f32_fp8(kv[i].w, false) * pp + acc[4 * i + 2]; acc[4 * i + 3] = __builtin_amdgcn_cvt_pk_f32_fp8(kv[i].w, true) * pp + acc[4 * i + 3]; } } while (0)
        unsigned k1 = myk[1];
        AT_LOAD(kA, (unsigned)myk[0]);
#pragma unroll 1
        for (int s = 0; s < per; s += 2) {
            const int s2 = s + 2 < per ? s + 2 : per - 1, s3 = s + 3 < per ? s + 3 : per - 1;
            const unsigned kn0 = myk[s2], kn1 = myk[s3];
            AT_LOAD(kB, k1);  AT_WAIT(kA); AT_STEP(kA);
            AT_LOAD(kA, kn0); AT_WAIT(kB); AT_STEP(kB);
            k1 = kn1;
        }
        asm volatile("s_waitcnt vmcnt(0)" : "+v"(kA[0]), "+v"(kA[1]), "+v"(kA[2]), "+v"(kA[3]), "+v"(kA[4]), "+v"(kA[5]), "+v"(kA[6]), "+v"(kA[7]) :: "memory");
#undef AT_LOAD
#undef AT_WAIT
#undef AT_STEP
        float ms = m; ms = fmaxf(ms, __shfl_xor(ms, 8)); ms = fmaxf(ms, __shfl_xor(ms, 16)); ms = fmaxf(ms, __shfl_xor(ms, 32));
        const float f = __builtin_amdgcn_exp2f(m - ms);
        float ls = l * f; ls += __shfl_xor(ls, 8); ls += __shfl_xor(ls, 16); ls += __shfl_xor(ls, 32);
        const float inv = 1.f / ls;
        float o[8];
#pragma unroll
        for (int e = 0; e < 8; ++e) o[e] = 0.f;
#pragma unroll
        for (int hf = 0; hf < 2; ++hf) {
            float* myrow = rw + lane * 36;
#pragma unroll
            for (int c = 0; c < 8; ++c) *(f32x4*)(myrow + 4 * c) = (f32x4){acc[16 * hf + 2 * c].x * f, acc[16 * hf + 2 * c].y * f, acc[16 * hf + 2 * c + 1].x * f, acc[16 * hf + 2 * c + 1].y * f};
            if ((j >> 2) == hf) {
#pragma unroll
                for (int jj = 0; jj < 8; ++jj) {
                    const float* r = rw + (8 * jj + h) * 36 + 8 * (j & 3);
                    const f32x4 a0 = *(const f32x4*)r, a1 = *(const f32x4*)(r + 4);
                    o[0] += a0.x; o[1] += a0.y; o[2] += a0.z; o[3] += a0.w; o[4] += a1.x; o[5] += a1.y; o[6] += a1.z; o[7] += a1.w;
                }
            }
        }
        const u32x4 graw = *(const u32x4*)(P + (size_t)t * NP + C_GB + 64 * h + 8 * j);
        const float gg[8] = {lo2f(graw.x), hi2f(graw.x), lo2f(graw.y), hi2f(graw.y), lo2f(graw.z), hi2f(graw.z), lo2f(graw.w), hi2f(graw.w)};
#pragma unroll
        for (int e = 0; e < 8; ++e) o[e] = o[e] * inv * (gg[e] / (1.f + __expf(-gg[e])));
        u32x4 ov; ov.x = pack2(o[0], o[1]); ov.y = pack2(o[2], o[3]); ov.z = pack2(o[4], o[5]); ov.w = pack2(o[6], o[7]);
        *(u32x4*)(YB + (size_t)t * 512 + 64 * h + 8 * j) = ov;
    }
}

constexpr int TK_CAP = 640, TK_NE = TK_CAP / 64, TK_RS = 96;
constexpr int TKO_CI = 32 * TK_CAP * 4 + 256, TKO_IKB = TKO_CI + 32 * TK_CAP * 2 + 128, TKO_HIST = TKO_IKB + 32768, TKO_FLAG = TKO_HIST + 4096;
static_assert(TKO_FLAG + 32 <= LDS_BYTES && (TKO_IKB % 16) == 0, "topk LDS map");
struct SelOut { unsigned thr, cgt; };
__device__ __forceinline__ unsigned wave_excl_scan(unsigned v, int lane, unsigned& total) {
    const unsigned incl = wave_incl_scan_dpp(v);
    total = (unsigned)__builtin_amdgcn_readlane((int)incl, 63);
    return incl - v;
}
template <bool EXACT>
__device__ __forceinline__ SelOut wave_select(const unsigned (&u)[TK_NE], const bool (&valid)[TK_NE], unsigned nvalid, unsigned* hist, int lane, unsigned R, unsigned slack) {
    unsigned an = 0xffffffffu, orr = 0u;
#pragma unroll
    for (int i = 0; i < TK_NE; ++i) if (valid[i]) { an &= u[i]; orr |= u[i]; }
    an = ~wave_or_dpp(~an); orr = wave_or_dpp(orr);
    SelOut o;
    const unsigned diff = an ^ orr;
    if (diff == 0u) { o.thr = an; o.cgt = 0u; return o; }
    int bits_left = 32 - __builtin_clz(diff);
    unsigned prefix = (bits_left == 32) ? 0u : ((an >> bits_left) << bits_left);
    unsigned rrem = R, m = nvalid;
#pragma unroll 1
    while (bits_left > 0) {
        const int w = bits_left < 8 ? bits_left : 8, shift = bits_left - w;
        *(u32x2*)(hist + 2 * lane) = (u32x2){0u, 0u};
        wave_lds_sync();
#pragma unroll
        for (int i = 0; i < TK_NE; ++i) {
            const bool act = valid[i] && (bits_left == 32 || ((u[i] ^ prefix) >> bits_left) == 0u);
            const unsigned d = (u[i] >> shift) & ((1u << w) - 1u);
            if (act) atomicAdd(hist + (d >> 1), (d & 1u) ? 0x10000u : 1u);
        }
        wave_lds_sync();
        const u32x2 hw = *(const u32x2*)(hist + 2 * lane);
        const unsigned bb[4] = {hw.x & 0xffffu, hw.x >> 16, hw.y & 0xffffu, hw.y >> 16};
        const unsigned hcnt = (bb[0] + bb[1]) + (bb[2] + bb[3]);
        const unsigned pincl = wave_incl_scan_dpp(hcnt);
        const unsigned ptot = (unsigned)__builtin_amdgcn_readlane((int)pincl, 63);
        const unsigned incl = ptot - pincl + hcnt;
        const unsigned excl = incl - hcnt;
        unsigned cum = excl, vv = 0u, cbef = 0u, hv = 0u; bool fnd = false;
#pragma unroll
        for (int b = 3; b >= 0; --b) {
            if (!fnd && rrem <= cum + bb[b]) { fnd = true; vv = 4u * (unsigned)lane + (unsigned)b; cbef = cum; hv = bb[b]; }
            cum += bb[b];
        }
        const unsigned long long fm = __ballot(excl < rrem && rrem <= incl);
        const int srcl = fm ? (__ffsll((long long)fm) - 1) : 0;
        prefix |= (unsigned)__builtin_amdgcn_readlane((int)vv, srcl) << shift;
        rrem -= (unsigned)__builtin_amdgcn_readlane((int)cbef, srcl);
        m = (unsigned)__builtin_amdgcn_readlane((int)hv, srcl);
        bits_left = shift;
        if (!EXACT && (R - rrem) + m <= R + slack) break;
    }
    o.thr = prefix; o.cgt = R - rrem; return o;
}

__device__ __forceinline__ void phase_topk(const Args& a, unsigned char* lds, int wg, int nwg) {
    const bf16_t* P = (const bf16_t*)(a.ws + WS_P);
    bf16_t* YB = (bf16_t*)(a.ws + WS_YB);
    float* cs = (float*)lds;
    unsigned short* ci = (unsigned short*)(lds + TKO_CI);
    unsigned char* ikb = lds + TKO_IKB;
    unsigned* flag = (unsigned*)(lds + TKO_FLAG);
    int tid_ = threadIdx.x;
    const int wave = __builtin_amdgcn_readfirstlane((int)(threadIdx.x >> 6));
    unsigned* hist = (unsigned*)(lds + TKO_HIST) + wave * 128;
    unsigned* ictr = (unsigned*)(a.ws + WS_CTL) + 4048;
    for (;;) {
        asm volatile("" : "+v"(tid_));
        const int tid = tid_, lane = tid & 63, l31 = lane & 31, hi = lane >> 5;
        __syncthreads();
        if (tid == 0) flag[0] = atomicAdd(ictr, 1u);
        __syncthreads();
        const int it = (int)flag[0];
        if (it >= 512) break;
        const int idx = 511 - it;
        const int chunk = idx >> 1, hf = idx & 1, t0 = chunk * 64 + hf * 32, n = (chunk + 1) * 64;
        unsigned short* slots = (unsigned short*)ikb + (4 * wave) * 256;
        float* rw = cs + (4 * wave) * TK_CAP;
        if (n <= 256) {
            const unsigned b4 = 4u * lane;
#pragma unroll
            for (int qq = 0; qq < 4; ++qq) *(u32x2*)(slots + qq * 256 + 4 * lane) = (u32x2){b4 | ((b4 + 1u) << 16), (b4 + 2u) | ((b4 + 3u) << 16)};
        } else {
        __syncthreads();
        if (tid < 5) flag[tid] = 0u;
        const int tq0 = t0 + 4 * wave;
        bf16x8 afr[4];
        {
            const int q = 2 * (l31 >> 4) + ((l31 >> 2) & 1), hh = (l31 & 3) + 4 * ((l31 >> 3) & 1);
#pragma unroll
            for (int ks = 0; ks < 4; ++ks) afr[ks] = *(const bf16x8*)(P + (size_t)(tq0 + q) * NP + C_IQ + hh * 64 + ks * 16 + hi * 8);
        }
        float wq[2][8];
#pragma unroll
        for (int rd = 0; rd < 2; ++rd) {
            const u32x4 wr = *(const u32x4*)(P + (size_t)(tq0 + 2 * rd + hi) * NP + C_IW);
            const float sc = 0.35355339059f * 0.125f;
            wq[rd][0] = lo2f(wr.x) * sc; wq[rd][1] = hi2f(wr.x) * sc; wq[rd][2] = lo2f(wr.y) * sc; wq[rd][3] = hi2f(wr.y) * sc;
            wq[rd][4] = lo2f(wr.z) * sc; wq[rd][5] = hi2f(wr.z) * sc; wq[rd][6] = lo2f(wr.w) * sc; wq[rd][7] = hi2f(wr.w) * sc;
        }
        unsigned cnt[2] = {0u, 0u}, tauu[2] = {0u, 0u};
        float tauf[2] = {-INFINITY, -INFINITY};
        float taus[2] = {-INFINITY, -INFINITY};
        const int qbase[2] = {(4 * wave + hi) * TK_CAP, (4 * wave + 2 + hi) * TK_CAP};
        const int nblk = (n + 127) >> 7;
        int pass = (nblk >= 12) ? 0 : 2;
#pragma unroll 1
        for (;;) {
        const int kstep = (pass == 0) ? 4 : 1, kfirst = (pass == 0) ? 3 : 0;
        const unsigned rkeep = (pass == 0) ? (unsigned)TK_RS : 256u;
        if (pass != 1) { cnt[0] = 0u; cnt[1] = 0u; }
        tauf[0] = (pass == 1) ? taus[0] : -INFINITY; tauf[1] = (pass == 1) ? taus[1] : -INFINITY;
        if (tid < 4) flag[tid] = 0u;
        u32x4 st[2];
        {
#pragma unroll
            for (int i = 0; i < 2; ++i) {
                const int cid = tid + 512 * i, row = kfirst * 128 + (cid >> 3), kc = cid & 7;
                st[i] = (row < n) ? *(const u32x4*)(P + (size_t)row * NP + C_IK + kc * 8) : (u32x4){0u, 0u, 0u, 0u};
                *(u32x4*)(ikb + swz128(cid >> 3, kc)) = st[i];
            }
        }
        __syncthreads();
        int itc = 0;
        for (int kb = kfirst, knext; kb < nblk; kb = knext, ++itc) {
            knext = kb + kstep;
            if (pass == 1 && (knext & 3) == 3) ++knext;
            const int key0 = kb * 128, keyn = knext * 128;
            const bool more = knext < nblk;
            if (tid == 0) flag[(itc + 1) & 3] = 0u;
            if (more) {
#pragma unroll
                for (int i = 0; i < 2; ++i) {
                    const int cid = tid + 512 * i, row = cid >> 3, kc = cid & 7;
                    st[i] = (keyn + row < n) ? *(const u32x4*)(P + (size_t)(keyn + row) * NP + C_IK + kc * 8) : (u32x4){0u, 0u, 0u, 0u};
                }
            }
            const unsigned char* kbuf = ikb + (itc & 1) * 16384;
            const int ntile = (n - key0 >= 128) ? 4 : ((n - key0) >> 5);
            for (int kt = 0; kt < ntile; ++kt) {
                f32x16 z = zero16();
#pragma unroll
                for (int ks = 0; ks < 4; ++ks) {
                    const bf16x8 bfr = *(const bf16x8*)(kbuf + swz128(kt * 32 + l31, 2 * ks + hi));
                    z = __builtin_amdgcn_mfma_f32_32x32x16_bf16(afr[ks], bfr, z, 0, 0, 0);
                }
                const int key = key0 + kt * 32 + l31;
#pragma unroll
                for (int e = 0; e < 16; ++e) { const float zf = z[e]; const int zi = __float_as_int(zf); z[e] = __int_as_float(zi > 0 ? zi : 0); }
                f32x2 sa = (f32x2){0.f, 0.f}, sb = (f32x2){0.f, 0.f};
#pragma unroll
                for (int hp = 0; hp < 4; ++hp) {
                    sa = (f32x2){z[2 * hp], z[2 * hp + 1]} * (f32x2){wq[0][2 * hp], wq[0][2 * hp + 1]} + sa;
                    sb = (f32x2){z[8 + 2 * hp], z[8 + 2 * hp + 1]} * (f32x2){wq[1][2 * hp], wq[1][2 * hp + 1]} + sb;
                }
                const float sc2[2] = {sa.x + sa.y, sb.x + sb.y};
#pragma unroll
                for (int rd = 0; rd < 2; ++rd) {
                    const float s = sc2[rd];
                    const bool pred = s >= tauf[rd];
                    const unsigned long long mask = __ballot(pred);
                    const unsigned m32 = hi ? (unsigned)(mask >> 32) : (unsigned)mask;
                    const unsigned pos = cnt[rd] + __popc(m32 & ((1u << l31) - 1u));
                    const bool ok = pred && pos < (unsigned)TK_CAP;
                    const int slot = ok ? (qbase[rd] + (int)pos) : (32 * TK_CAP + lane);
                    cs[slot] = s; ci[slot] = (unsigned short)key;
                    cnt[rd] += __popc(m32);
                }
            }
            if (more) {
                unsigned char* nbuf = ikb + ((itc + 1) & 1) * 16384;
#pragma unroll
                for (int i = 0; i < 2; ++i) { const int cid = tid + 512 * i; *(u32x4*)(nbuf + swz128(cid >> 3, cid & 7)) = st[i]; }
            }
            if (cnt[0] > (unsigned)TK_CAP) cnt[0] = TK_CAP;
            if (cnt[1] > (unsigned)TK_CAP) cnt[1] = TK_CAP;
            if (cnt[0] > (unsigned)(TK_CAP - 128) || cnt[1] > (unsigned)(TK_CAP - 128)) flag[itc & 3] = 1u;
            __syncthreads();
            if (flag[itc & 3] != 0u && more) {
#pragma unroll 1
                for (int qq = 0; qq < 4; ++qq) {
                    const int rd = qq >> 1, hq = qq & 1;
                    const unsigned cq = __builtin_amdgcn_readlane(rd ? cnt[1] : cnt[0], 32 * hq);
                    if (cq <= rkeep + 32u) continue;
                    const int qi = 4 * wave + qq;
                    unsigned u[TK_NE]; bool valid[TK_NE]; float sv[TK_NE]; unsigned iv[TK_NE];
#pragma unroll
                    for (int i = 0; i < TK_NE; ++i) {
                        const unsigned j = TK_NE * lane + i;
                        valid[i] = j < cq;
                        sv[i] = cs[qi * TK_CAP + j];
                        iv[i] = (unsigned)ci[qi * TK_CAP + j];
                        u[i] = f2key(sv[i]);
                    }
                    const SelOut so = wave_select<false>(u, valid, cq, hist, lane, rkeep, 32u);
                    unsigned kc = 0u;
#pragma unroll
                    for (int i = 0; i < TK_NE; ++i) kc += (valid[i] && u[i] >= so.thr) ? 1u : 0u;
                    unsigned total;
                    unsigned pos = wave_excl_scan(kc, lane, total);
#pragma unroll
                    for (int i = 0; i < TK_NE; ++i) {
                        const bool keep = valid[i] && u[i] >= so.thr;
                        const int slot = keep ? (qi * TK_CAP + (int)pos) : (32 * TK_CAP + lane);
                        cs[slot] = sv[i]; ci[slot] = (unsigned short)iv[i];
                        pos += keep ? 1u : 0u;
                    }
                    wave_lds_sync();
                    if (hi == hq) {
                        const float tf = __uint_as_float((so.thr & 0x80000000u) ? (so.thr & 0x7fffffffu) : ~so.thr);
                        if (rd) { cnt[1] = total; tauu[1] = so.thr; tauf[1] = tf; } else { cnt[0] = total; tauu[0] = so.thr; tauf[0] = tf; }
                    }
                }
            }
        }
        if (pass == 0) {
#pragma unroll 1
            for (int qq = 0; qq < 4; ++qq) {
                const int rd = qq >> 1, hq = qq & 1;
                const unsigned cq = __builtin_amdgcn_readlane(rd ? cnt[1] : cnt[0], 32 * hq);
                const int qi = 4 * wave + qq;
                unsigned u[TK_NE]; bool valid[TK_NE];
#pragma unroll
                for (int i = 0; i < TK_NE; ++i) {
                    const unsigned j = TK_NE * lane + i;
                    valid[i] = j < cq;
                    u[i] = f2key(cs[qi * TK_CAP + j]);
                }
                const SelOut so = wave_select<true>(u, valid, cq, hist, lane, (unsigned)TK_RS, 0u);
                const unsigned thr = cq >= (unsigned)TK_RS ? so.thr : 0u;
                unsigned kc = 0u;
#pragma unroll
                for (int i = 0; i < TK_NE; ++i) kc += (valid[i] && u[i] >= thr) ? 1u : 0u;
                unsigned total;
                unsigned pos = wave_excl_scan(kc, lane, total);
                float sv[TK_NE]; unsigned iv[TK_NE];
#pragma unroll
                for (int i = 0; i < TK_NE; ++i) { const unsigned j = TK_NE * lane + i; sv[i] = cs[qi * TK_CAP + j]; iv[i] = (unsigned)ci[qi * TK_CAP + j]; }
                wave_lds_sync();
#pragma unroll
                for (int i = 0; i < TK_NE; ++i) {
                    const bool keep = valid[i] && u[i] >= thr;
                    const int slot = keep ? (qi * TK_CAP + (int)pos) : (32 * TK_CAP + lane);
                    cs[slot] = sv[i]; ci[slot] = (unsigned short)iv[i];
                    pos += keep ? 1u : 0u;
                }
                wave_lds_sync();
                if (hi == hq) {
                    const float tf = thr ? __uint_as_float((thr & 0x80000000u) ? (thr & 0x7fffffffu) : ~thr) : -INFINITY;
                    if (rd) { taus[1] = tf; cnt[1] = total; } else { taus[0] = tf; cnt[0] = total; }
                }
            }
            pass = 1;
            continue;
        }
        if (pass == 1) {
            if (cnt[0] < 256u || cnt[1] < 256u) flag[4] = 1u;
            __syncthreads();
            if (flag[4] == 0u) break;
            pass = 2;
            continue;
        }
        break;
        }
#pragma unroll 1
        for (int qq = 0; qq < 4; ++qq) {
            const int rd = qq >> 1, hq = qq & 1;
            const unsigned cq = __builtin_amdgcn_readlane(rd ? cnt[1] : cnt[0], 32 * hq);
            const int qi = 4 * wave + qq;
            unsigned u[TK_NE]; bool valid[TK_NE]; unsigned iv[TK_NE];
#pragma unroll
            for (int i = 0; i < TK_NE; ++i) {
                const unsigned j = TK_NE * lane + i;
                valid[i] = j < cq;
                u[i] = f2key(cs[qi * TK_CAP + j]);
                iv[i] = (unsigned)ci[qi * TK_CAP + j];
            }
            const SelOut so = wave_select<true>(u, valid, cq, hist, lane, 256u, 0u);
            const unsigned need = 256u - so.cgt;
            unsigned ge = 0u, gg = 0u;
#pragma unroll
            for (int i = 0; i < TK_NE; ++i) { ge += (valid[i] && u[i] == so.thr) ? 1u : 0u; gg += (valid[i] && u[i] > so.thr) ? 1u : 0u; }
            unsigned tot;
            const unsigned ebase = wave_excl_scan(ge, lane, tot);
            const unsigned etake = ebase >= need ? 0u : ((need - ebase) < ge ? (need - ebase) : ge);
            unsigned pos = wave_excl_scan(gg + etake, lane, tot);
            unsigned er = ebase;
            unsigned short* dst = slots + qq * 256;
#pragma unroll
            for (int i = 0; i < TK_NE; ++i) {
                const bool gt = valid[i] && u[i] > so.thr, eq = valid[i] && u[i] == so.thr;
                const bool take = gt || (eq && er < need);
                if (take && pos < 256u) dst[pos] = (unsigned short)iv[i];
                pos += take ? 1u : 0u; er += eq ? 1u : 0u;
            }
        }
        }
        wave_lds_sync();
        asm volatile("" : "+v"(tid_));
#pragma unroll 1
        for (int qq = 0; qq < 4; ++qq) attn_query(P, a.ws + WS_KV, YB, t0 + 4 * wave + qq, n < 256 ? n : 256, slots + qq * 256, rw, tid_ & 63);
    }
}

__device__ __forceinline__ int swzrow(int row, int chunk, int rowbytes) { return row * rowbytes + ((chunk ^ (row & 15)) << 4); }

__device__ __forceinline__ void phase_out(const Args& a, unsigned char* lds, int wg, int nwg) {
    const bf16_t* YA = (const bf16_t*)(a.ws + WS_YA);
    const bf16_t* YB = (const bf16_t*)(a.ws + WS_YB);
    const bf16_t* WfA = (const bf16_t*)(a.ws + WS_WTA);
    const bf16_t* WfB = (const bf16_t*)(a.ws + WS_WTB);
    const bf16_t* WfO = (const bf16_t*)(a.ws + WS_WTO);
    bf16_t* P = (bf16_t*)(a.ws + WS_P);
    const bf16_t* G = (const bf16_t*)a.out;
    const float* gate = (const float*)(a.ws + WS_MOD) + 2048;
    unsigned char* sYA = lds; unsigned char* sYB = lds + 65536; unsigned char* sM = lds;
    int tid_ = threadIdx.x;
    const int wave = __builtin_amdgcn_readfirstlane((int)(threadIdx.x >> 6));
    for (int tile = wg; tile < 256; tile += nwg) {
        asm volatile("" : "+v"(tid_)); const int tid = tid_, lane = tid & 63;
        const int m0 = tile * 64;
        __syncthreads();
#pragma unroll
        for (int i = 0; i < 8; ++i) {
            const int cid = tid + 512 * i, row = cid >> 6, ch = cid & 63;
            *(u32x4*)(sYA + swzrow(row, ch, 1024)) = *(const u32x4*)(YA + (size_t)(m0 + row) * 512 + ch * 8);
            *(u32x4*)(sYB + swzrow(row, ch, 1024)) = *(const u32x4*)(YB + (size_t)(m0 + row) * 512 + ch * 8);
        }
        __syncthreads();
        const int l15 = lane & 15, q4 = lane >> 4;
#pragma unroll 1
        for (int half = 0; half < 2; ++half) {
            f32x4 ca[4][4], cb[4][4];
#pragma unroll
            for (int rt = 0; rt < 4; ++rt)
#pragma unroll
                for (int tt = 0; tt < 4; ++tt) { ca[rt][tt] = (f32x4){0.f, 0.f, 0.f, 0.f}; cb[rt][tt] = (f32x4){0.f, 0.f, 0.f, 0.f}; }
            const int R0 = 8 * wave + 4 * half;
            const bf16_t* pa = WfA + (size_t)R0 * 16 * 64 * 8;
            const bf16_t* pb = WfB + (size_t)R0 * 16 * 64 * 8;
            const unsigned lane16 = (unsigned)lane * 16u;
            bf16x8 sA[8], sB[8];
#define WAB_LOAD(dst, ksv) do { _Pragma("unroll") for (int rt = 0; rt < 4; ++rt) { \
                const bf16_t* p1_ = pa + ((size_t)rt * 16 + (ksv)) * 512; const bf16_t* p2_ = pb + ((size_t)rt * 16 + (ksv)) * 512; \
                asm volatile("global_load_dwordx4 %0, %1, %2" : "=v"(dst[rt]) : "v"(lane16), "s"(p1_) : "memory"); \
                asm volatile("global_load_dwordx4 %0, %1, %2" : "=v"(dst[4 + rt]) : "v"(lane16), "s"(p2_) : "memory"); } } while (0)
#define WAB_WAIT(dst) asm volatile("s_waitcnt vmcnt(8)" : "+v"(dst[0]), "+v"(dst[1]), "+v"(dst[2]), "+v"(dst[3]), "+v"(dst[4]), "+v"(dst[5]), "+v"(dst[6]), "+v"(dst[7]) :: "memory")
#define WAB_STEP(w_, ksv) do { _Pragma("unroll") for (int th = 0; th < 2; ++th) { bf16x8 by[2], bb[2]; \
                _Pragma("unroll") for (int t2 = 0; t2 < 2; ++t2) { by[t2] = *(const bf16x8*)(sYA + swzrow(16 * (2 * th + t2) + l15, 4 * (ksv) + q4, 1024)); bb[t2] = *(const bf16x8*)(sYB + swzrow(16 * (2 * th + t2) + l15, 4 * (ksv) + q4, 1024)); } \
                _Pragma("unroll") for (int rt = 0; rt < 4; ++rt) _Pragma("unroll") for (int t2 = 0; t2 < 2; ++t2) { \
                    ca[rt][2 * th + t2] = __builtin_amdgcn_mfma_f32_16x16x32_bf16(w_[rt], by[t2], ca[rt][2 * th + t2], 0, 0, 0); \
                    cb[rt][2 * th + t2] = __builtin_amdgcn_mfma_f32_16x16x32_bf16(w_[4 + rt], bb[t2], cb[rt][2 * th + t2], 0, 0, 0); } } } while (0)
            asm volatile("s_waitcnt vmcnt(0)" ::: "memory");
            WAB_LOAD(sA, 0);
#pragma unroll 1
            for (int ks = 0; ks < 16; ks += 2) {
                WAB_LOAD(sB, ks + 1);                        WAB_WAIT(sA); WAB_STEP(sA, ks);
                WAB_LOAD(sA, (ks + 2 < 16) ? ks + 2 : 15);   WAB_WAIT(sB); WAB_STEP(sB, ks + 1);
            }
            asm volatile("s_waitcnt vmcnt(0)" : "+v"(sA[0]), "+v"(sA[1]), "+v"(sA[2]), "+v"(sA[3]), "+v"(sA[4]), "+v"(sA[5]), "+v"(sA[6]), "+v"(sA[7]) :: "memory");
#undef WAB_LOAD
#undef WAB_WAIT
#undef WAB_STEP
#pragma unroll
            for (int tt = 0; tt < 4; ++tt) {
                const int n = 128 * wave + 64 * half + 16 * q4, m = m0 + 16 * tt + l15;
                const u32x4 ga0 = *(const u32x4*)(G + (size_t)m * 2048 + n), ga1 = *(const u32x4*)(G + (size_t)m * 2048 + n + 8);
                const u32x4 gb0 = *(const u32x4*)(G + (size_t)m * 2048 + 1024 + n), gb1 = *(const u32x4*)(G + (size_t)m * 2048 + 1024 + n + 8);
                const unsigned gaw[8] = {ga0.x, ga0.y, ga0.z, ga0.w, ga1.x, ga1.y, ga1.z, ga1.w};
                const unsigned gbw[8] = {gb0.x, gb0.y, gb0.z, gb0.w, gb1.x, gb1.y, gb1.z, gb1.w};
                unsigned mw[8];
#pragma unroll
                for (int p = 0; p < 8; ++p) {
                    const float v0 = lo2f(gaw[p]) * ca[p >> 1][tt][2 * (p & 1)] + lo2f(gbw[p]) * cb[p >> 1][tt][2 * (p & 1)];
                    const float v1 = hi2f(gaw[p]) * ca[p >> 1][tt][2 * (p & 1) + 1] + hi2f(gbw[p]) * cb[p >> 1][tt][2 * (p & 1) + 1];
                    mw[p] = pack2(v0, v1);
                }
                bf16_t* dst = P + (size_t)m * NP + C_Q + n;
                *(u32x4*)dst = (u32x4){mw[0], mw[1], mw[2], mw[3]};
                *(u32x4*)(dst + 8) = (u32x4){mw[4], mw[5], mw[6], mw[7]};
            }
        }
        asm volatile("s_waitcnt vmcnt(0)" ::: "memory");
        __syncthreads();
        int tidb_ = threadIdx.x; asm volatile("" : "+v"(tidb_));
#pragma unroll
        for (int i = 0; i < 16; ++i) {
            const int cid = tidb_ + 512 * i, row = cid >> 7, ch = cid & 127;
            *(u32x4*)(sM + swzrow(row, ch, 2048)) = *(const u32x4*)(P + (size_t)(m0 + row) * NP + C_Q + ch * 8);
        }
        __syncthreads();
        {
            const int lane = tidb_ & 63, l15 = lane & 15, q4 = lane >> 4;
            f32x4 acc[8][4];
#pragma unroll
            for (int rt = 0; rt < 8; ++rt)
#pragma unroll
                for (int tt = 0; tt < 4; ++tt) acc[rt][tt] = (f32x4){0.f, 0.f, 0.f, 0.f};
            const bf16_t* po = WfO + (size_t)(8 * wave) * 32 * 64 * 8;
            const unsigned lane16 = (unsigned)lane * 16u;
            bf16x8 wA[8], wB[8];
#define WO_LOAD(dst, ksv) do { _Pragma("unroll") for (int rt = 0; rt < 8; ++rt) { const bf16_t* p_ = po + ((size_t)rt * 32 + (ksv)) * 512; \
                asm volatile("global_load_dwordx4 %0, %1, %2" : "=v"(dst[rt]) : "v"(lane16), "s"(p_) : "memory"); } } while (0)
#define WO_WAIT(dst) asm volatile("s_waitcnt vmcnt(8)" : "+v"(dst[0]), "+v"(dst[1]), "+v"(dst[2]), "+v"(dst[3]), "+v"(dst[4]), "+v"(dst[5]), "+v"(dst[6]), "+v"(dst[7]) :: "memory")
#define WO_STEP(w_, ksv) do { bf16x8 bm[4]; _Pragma("unroll") for (int tt = 0; tt < 4; ++tt) bm[tt] = *(const bf16x8*)(sM + swzrow(16 * tt + l15, 4 * (ksv) + q4, 2048)); \
                _Pragma("unroll") for (int rt = 0; rt < 8; ++rt) _Pragma("unroll") for (int tt = 0; tt < 4; ++tt) \
                    acc[rt][tt] = __builtin_amdgcn_mfma_f32_16x16x32_bf16(w_[rt], bm[tt], acc[rt][tt], 0, 0, 0); } while (0)
            asm volatile("s_waitcnt vmcnt(0)" ::: "memory");
            WO_LOAD(wA, 0);
#pragma unroll 1
            for (int ks = 0; ks < 32; ks += 2) {
                WO_LOAD(wB, ks + 1);                        WO_WAIT(wA); WO_STEP(wA, ks);
                WO_LOAD(wA, (ks + 2 < 32) ? ks + 2 : 31);   WO_WAIT(wB); WO_STEP(wB, ks + 1);
            }
            asm volatile("s_waitcnt vmcnt(0)" : "+v"(wA[0]), "+v"(wA[1]), "+v"(wA[2]), "+v"(wA[3]), "+v"(wA[4]), "+v"(wA[5]), "+v"(wA[6]), "+v"(wA[7]) :: "memory");
#undef WO_LOAD
#undef WO_WAIT
#undef WO_STEP
#pragma unroll
            for (int g = 0; g < 2; ++g)
#pragma unroll
                for (int tt = 0; tt < 4; ++tt) {
                    const int n = 128 * wave + 64 * g + 16 * q4, m = m0 + 16 * tt + l15;
#pragma unroll
                    for (int r4 = 0; r4 < 4; ++r4) {
                        const f32x4 xv = *(const f32x4*)(a.x + (size_t)m * 1024 + n + 4 * r4);
                        const f32x4 gv = *(const f32x4*)(gate + n + 4 * r4);
                        const f32x4 av = acc[4 * g + r4][tt];
                        f32x4 o;
                        o.x = xv.x + gv.x * av.x; o.y = xv.y + gv.y * av.y; o.z = xv.z + gv.z * av.z; o.w = xv.w + gv.w * av.w;
                        *(f32x4*)(a.out + (size_t)m * 1024 + n + 4 * r4) = o;
                    }
                }
        }
    }
}

#define XB_TMO      128
#define XB_XCNT(j)  (256  + 64 * (j))
#define XB_XSUB(j)  (1280 + 64 * (j))
#define XB_XGEN(j)  (2304 + 64 * (j))
#define XB_TOP      3328
#define XB_TOPGEN   3392
#define XCD_BAR_WORDS 3456
#define XB_SPIN_CAP (1u << 22)
__device__ __forceinline__ unsigned xb_ld(unsigned* p)              { return __hip_atomic_load(p, __ATOMIC_RELAXED, __HIP_MEMORY_SCOPE_AGENT); }
__device__ __forceinline__ unsigned xb_add(unsigned* p, unsigned v) { return __hip_atomic_fetch_add(p, v, __ATOMIC_RELAXED, __HIP_MEMORY_SCOPE_AGENT); }
__device__ __forceinline__ unsigned xb_xcc_id() { return (unsigned)__builtin_amdgcn_s_getreg((3 << 11) | 20) & 0xFu; }
#define XB_SPIN(cond, bar) do { unsigned _sp = 0; while (cond) { __builtin_amdgcn_s_sleep(1); \
    if ((++_sp & 255u) == 0u) { if (xb_ld(&(bar)[XB_TMO])) break; if (_sp > XB_SPIN_CAP) { atomicAdd(&(bar)[XB_TMO], 1u); break; } } } } while (0)
__device__ __forceinline__ void xcd_barrier_post(unsigned* bar) {
    if (threadIdx.x == 0) (void)xb_add(&bar[XB_XCNT(xb_xcc_id())], 1u);
}
__device__ __forceinline__ void xcd_barrier_complete(unsigned* bar, unsigned x, unsigned& nloc, unsigned& nx) {
    const unsigned G = gridDim.x * gridDim.y * gridDim.z;
    unsigned sum, cnt, mine, sp = 0u;
    for (;;) {
        sum = 0u; cnt = 0u; mine = 0u;
#pragma unroll
        for (unsigned j = 0; j < 16; ++j) { const unsigned c = xb_ld(&bar[XB_XCNT(j)]); sum += c; cnt += (c > 0u) ? 1u : 0u; mine = (j == x) ? c : mine; }
        if (sum == G) break;
        __builtin_amdgcn_s_sleep(1);
        if ((++sp & 255u) == 0u) { if (xb_ld(&bar[XB_TMO])) break; if (sp > XB_SPIN_CAP) { atomicAdd(&bar[XB_TMO], 1u); break; } }
    }
    nloc = mine > 0u ? mine : 1u; nx = cnt > 0u ? cnt : 1u;
}
__device__ __forceinline__ void xcd_barrier(unsigned* bar) {
    asm volatile("s_waitcnt vmcnt(0)" ::: "memory");
    __syncthreads();
    if (threadIdx.x == 0) {
        __builtin_amdgcn_s_waitcnt(0);
        struct { unsigned x; } b; b.x = xb_xcc_id();
        unsigned* slot = bar + XCD_BAR_WORDS + 2 * blockIdx.x;
        unsigned nloc = xb_ld(slot), nx = xb_ld(slot + 1);
        if (nloc == 0u) { xcd_barrier_complete(bar, b.x, nloc, nx); __hip_atomic_store(slot, nloc, __ATOMIC_RELAXED, __HIP_MEMORY_SCOPE_AGENT); __hip_atomic_store(slot + 1, nx, __ATOMIC_RELAXED, __HIP_MEMORY_SCOPE_AGENT); }
        const unsigned old = xb_add(&bar[XB_XSUB(b.x)], 1u);
        const unsigned gen = old / nloc;
        if (old + 1u == (gen + 1u) * nloc) {
            __builtin_amdgcn_fence(__ATOMIC_RELEASE, "agent");
            asm volatile("s_waitcnt vmcnt(0)" ::: "memory");
            const unsigned og = xb_add(&bar[XB_TOP], 1u);
            const unsigned tg = og / nx;
            if (og + 1u == (tg + 1u) * nx) xb_add(&bar[XB_TOPGEN], 1u);
            else XB_SPIN(xb_ld(&bar[XB_TOPGEN]) == tg, bar);
            __builtin_amdgcn_fence(__ATOMIC_ACQUIRE, "agent");
            xb_add(&bar[XB_XGEN(b.x)], 1u);
            asm volatile("s_waitcnt vmcnt(0)" ::: "memory");
        } else {
            XB_SPIN(xb_ld(&bar[XB_XGEN(b.x)]) == gen, bar);
            __builtin_amdgcn_fence(__ATOMIC_ACQUIRE, "agent");
            asm volatile("s_waitcnt vmcnt(0)" ::: "memory");
        }
    }
    __syncthreads();
}

#define DECL_LDS extern __shared__ __attribute__((aligned(16))) unsigned char lds[]
__global__ void __launch_bounds__(NTHR) mk_fwd(Args a) {
    DECL_LDS;
    const int wg = blockIdx.x, nwg = gridDim.x;
    unsigned* bar = (unsigned*)(a.ws + WS_CTL);
    xcd_barrier_post(bar);
    convert_weightT<1>(a.w_in, 1024, 6856, (bf16_t*)(a.ws + WS_WTIN), NW, (float*)lds, wg, nwg);
    convert_weightF(a.w_a_out, 512, 1024, (bf16_t*)(a.ws + WS_WTA), 1024, (float*)lds, wg, nwg);
    convert_weightF(a.w_b_out, 512, 1024, (bf16_t*)(a.ws + WS_WTB), 1024, (float*)lds, wg, nwg);
    convert_weightF(a.w_o, 1024, 1024, (bf16_t*)(a.ws + WS_WTO), 1024, (float*)lds, wg, nwg);
    convert_weightT<2>(a.w_up, 64, 512, (bf16_t*)(a.ws + WS_WUPT), 512, (float*)lds, wg, nwg);
    convert_weightT<2>(a.a_up, 64, 512, (bf16_t*)(a.ws + WS_AUPT), 512, (float*)lds, wg, nwg);
    phase_ada(a, (float*)lds, wg, nwg);
    xcd_barrier(bar);
    phase_h(a, wg, nwg);
    xcd_barrier(bar);
    phase_gemm1(a, lds, wg, nwg);
    xcd_barrier(bar);
    phase_rwkv_chunk<1>(a, lds, wg, nwg);
    xcd_barrier(bar);
    phase_rwkv_scan(a, wg);
    phase_topk(a, lds, wg, nwg);
    xcd_barrier(bar);
    phase_rwkv_chunk<2>(a, lds, wg, nwg);
    asm volatile("s_waitcnt vmcnt(0)" ::: "memory");
    __syncthreads();
    phase_out(a, lds, wg, nwg);
}

extern "C" void kernel_launch(void* const* d_in, const int* in_sizes, int n_in, void* d_out, int out_size, void* d_ws, size_t ws_size, hipStream_t stream) {
    static int grid = 0;
    if (grid == 0) {
        if (n_in != 21 || ws_size < WS_END || out_size != M_TOK * DM) { fprintf(stderr, "kernel_launch: unexpected shapes n_in %d ws %zu out %d\n", n_in, ws_size, out_size); grid = -1; return; }
        int dev = 0, cus = 0;
        if (hipGetDevice(&dev) != hipSuccess || hipDeviceGetAttribute(&cus, hipDeviceAttributeMultiprocessorCount, dev) != hipSuccess) { grid = -1; return; }
        if (hipFuncSetAttribute((const void*)mk_fwd, hipFuncAttributeMaxDynamicSharedMemorySize, LDS_BYTES) != hipSuccess) { fprintf(stderr, "kernel_launch: hipFuncSetAttribute failed\n"); grid = -1; return; }
        int per_cu = 0;
        if (hipOccupancyMaxActiveBlocksPerMultiprocessor(&per_cu, (const void*)mk_fwd, NTHR, LDS_BYTES) != hipSuccess || per_cu < 1) { fprintf(stderr, "kernel_launch: occupancy query says %d workgroups per CU\n", per_cu); (void)hipGetLastError(); }
        grid = cus;
    }
    if (grid < 0) return;
    (void)hipMemsetAsync((char*)d_ws + WS_CTL, 0, 16384, stream);
    Args a{};
    const float** pp = (const float**)&a;
    for (int i = 0; i < 21; ++i) pp[i] = (const float*)d_in[i];
    a.out = (float*)d_out; a.ws = (unsigned char*)d_ws;
    hipLaunchKernelGGL(mk_fwd, dim3(grid), dim3(NTHR), LDS_BYTES, stream, a);
}
```
